# Optimizing an MI355X kernel written in HIP

```python
import math
import jax, jax.numpy as jnp
from jax import lax
import numpy as np

D_MODEL = 1024
BATCH = 16
SEQ = 2048
DEPTH = 2

ATT_HEADS = 8
ATT_HEAD_DIM = 64
ATT_WIDTH = ATT_HEADS * ATT_HEAD_DIM
Q_BLOCK = 128
SSM_GROUP = 16
SSM_WIDTH = D_MODEL // 2
SSM_GROUPS = SSM_WIDTH // SSM_GROUP
SSM_STATE = 64
DT_MIN = 1e-3
DT_MAX = 1e-1
D_FF = 256 * ((8 * D_MODEL // 3 + 255) // 256)
N_EXPERTS = 8
TOP_K = 2
N_DENSE = (DEPTH + 1) // 2
N_MOE = DEPTH // 2
N_IN = 3 * ATT_WIDTH + ATT_HEADS + SSM_WIDTH + 2 * D_MODEL
EPS = 1e-6

kernel_name = 'fox_s5_gated_hybrid_moe_block'


def _rmsnorm(x, g):
    xf = x.astype(jnp.float32)
    y = xf * lax.rsqrt(jnp.mean(xf * xf, axis=-1, keepdims=True) + EPS)
    return (y * g.astype(jnp.float32)).astype(x.dtype)


def _forgetting_attention(q, k, v, log_f):
    bsz, seq, heads, dh = q.shape
    nblk = seq // Q_BLOCK
    cum = jnp.cumsum(log_f, axis=1).transpose(0, 2, 1)
    kh = k.transpose(0, 2, 1, 3)
    vh = v.transpose(0, 2, 1, 3)
    q_blocks = q.transpose(0, 2, 1, 3).reshape(bsz, heads, nblk, Q_BLOCK, dh).transpose(2, 0, 1, 3, 4)
    c_blocks = cum.reshape(bsz, heads, nblk, Q_BLOCK).transpose(2, 0, 1, 3)
    starts = jnp.arange(nblk, dtype=jnp.int32) * Q_BLOCK
    key_pos = jnp.arange(seq, dtype=jnp.int32)
    scale = dh ** -0.5

    def one_block(args):
        qb, cb, s0 = args
        logits = jnp.einsum('bhqd,bhkd->bhqk', qb, kh, preferred_element_type=jnp.float32) * scale
        logits = logits + cb[..., None] - cum[:, :, None, :]
        q_pos = s0 + jnp.arange(Q_BLOCK, dtype=jnp.int32)
        causal = q_pos[:, None] >= key_pos[None, :]
        logits = jnp.where(causal, logits, -jnp.inf)
        p = jax.nn.softmax(logits, axis=-1)
        return jnp.einsum('bhqk,bhkd->bhqd', p.astype(vh.dtype), vh)

    out = lax.map(one_block, (q_blocks, c_blocks, starts))
    return out.transpose(1, 0, 3, 2, 4).reshape(bsz, seq, heads * dh)


def _s5(u, lam_re, lam_im, log_dt, b_re, b_im, c_re, c_im, d_skip, w_glu, b_glu):
    bsz, seq, _ = u.shape
    f32 = jnp.float32
    uf = u.astype(f32).reshape(bsz, seq, SSM_GROUPS, SSM_GROUP)
    lr, li = lam_re.astype(f32), lam_im.astype(f32)
    dt = jnp.exp(log_dt.astype(f32))[:, None]
    mag = jnp.exp(lr * dt)
    ang = li * dt
    a_re, a_im = mag * jnp.cos(ang), mag * jnp.sin(ang)
    n_re, n_im = a_re - 1.0, a_im
    den = lr * lr + li * li
    k_re = (n_re * lr + n_im * li) / den
    k_im = (n_im * lr - n_re * li) / den
    br, bi = b_re.astype(f32), b_im.astype(f32)
    bb_re = k_re[..., None] * br - k_im[..., None] * bi
    bb_im = k_re[..., None] * bi + k_im[..., None] * br
    bu_re = jnp.einsum('blgh,gph->blgp', uf, bb_re)
    bu_im = jnp.einsum('blgh,gph->blgp', uf, bb_im)
    a_re_t = jnp.broadcast_to(a_re, (1, seq, SSM_GROUPS, SSM_STATE))
    a_im_t = jnp.broadcast_to(a_im, (1, seq, SSM_GROUPS, SSM_STATE))

    def combine(e1, e2):
        a1r, a1i, b1r, b1i = e1
        a2r, a2i, b2r, b2i = e2
        return (a2r * a1r - a2i * a1i,
                a2r * a1i + a2i * a1r,
                a2r * b1r - a2i * b1i + b2r,
                a2r * b1i + a2i * b1r + b2i)

    _, _, s_re, s_im = lax.associative_scan(combine, (a_re_t, a_im_t, bu_re, bu_im), axis=1)
    y = (jnp.einsum('blgp,ghp->blgh', s_re, c_re.astype(f32))
         - jnp.einsum('blgp,ghp->blgh', s_im, c_im.astype(f32))
         + d_skip.astype(f32) * uf)
    y = jax.nn.gelu(y.reshape(bsz, seq, SSM_WIDTH))
    y = y * jax.nn.sigmoid(y @ w_glu.astype(f32) + b_glu.astype(f32))
    return y.astype(u.dtype)


def _swiglu(t, w1, w3, w2):
    return (jax.nn.silu(t @ w1) * (t @ w3)) @ w2


def _moe(h, w_router, b_router, w1, w3, w2):
    bsz, seq, d = h.shape
    t = h.reshape(-1, d)
    logits = (t @ w_router + b_router).astype(jnp.float32)
    top_val, top_idx = lax.top_k(logits, TOP_K)
    top_w = jax.nn.softmax(top_val, axis=-1)
    gates = jnp.sum(jax.nn.one_hot(top_idx, N_EXPERTS, dtype=jnp.float32) * top_w[..., None], axis=1)
    out = jnp.zeros_like(t)
    for e in range(N_EXPERTS):
        out = out + gates[:, e:e + 1].astype(t.dtype) * _swiglu(t, w1[e], w3[e], w2[e])
    return out.reshape(bsz, seq, d)


def setup_inputs(seed: int = 0) -> dict:
    key = jax.random.key(seed)
    ks = jax.random.split(key, 32)
    f32 = jnp.float32
    D = D_MODEL
    G, P, Hc = SSM_GROUPS, SSM_STATE, SSM_GROUP

    def nrm(k, shape, scale):
        return jax.random.normal(k, shape, f32) * scale

    n_idx = jnp.arange(P, dtype=f32)
    return {
        'x': nrm(ks[0], (BATCH, SEQ, D), 1.0),
        'c': nrm(ks[1], (BATCH, D), 1.0),
        'w_ada': nrm(ks[2], (DEPTH, D, 6 * D), D ** -0.5),
        'b_ada': nrm(ks[3], (DEPTH, 6 * D), 0.02),
        'g_mix': 1.0 + nrm(ks[4], (DEPTH, D), 0.05),
        'w_in': nrm(ks[5], (DEPTH, D, N_IN), D ** -0.5),
        'b_forget': 2.0 + nrm(ks[6], (DEPTH, ATT_HEADS), 0.5),
        'b_gate': nrm(ks[7], (DEPTH, 2 * D), 0.02),
        'lam_re': -0.5 + nrm(ks[8], (DEPTH, G, P), 0.01),
        'lam_im': math.pi * n_idx + nrm(ks[9], (DEPTH, G, P), 0.01),
        'log_dt': jax.random.uniform(ks[10], (DEPTH, G), f32, math.log(DT_MIN), math.log(DT_MAX)),
        'b_re': nrm(ks[11], (DEPTH, G, P, Hc), (2 * Hc) ** -0.5),
        'b_im': nrm(ks[12], (DEPTH, G, P, Hc), (2 * Hc) ** -0.5),
        'c_re': nrm(ks[13], (DEPTH, G, Hc, P), P ** -0.5),
        'c_im': nrm(ks[14], (DEPTH, G, Hc, P), P ** -0.5),
        'd_skip': nrm(ks[15], (DEPTH, G, Hc), 1.0),
        'w_glu': nrm(ks[16], (DEPTH, SSM_WIDTH, SSM_WIDTH), SSM_WIDTH ** -0.5),
        'b_glu': nrm(ks[17], (DEPTH, SSM_WIDTH), 0.02),
        'w_proj_att': nrm(ks[18], (DEPTH, ATT_WIDTH, D), ATT_WIDTH ** -0.5),
        'w_proj_ssm': nrm(ks[19], (DEPTH, SSM_WIDTH, D), SSM_WIDTH ** -0.5),
        'w_out': nrm(ks[20], (DEPTH, D, D), D ** -0.5),
        'g_ffn': 1.0 + nrm(ks[21], (DEPTH, D), 0.05),
        'w1_dense': nrm(ks[22], (N_DENSE, D, D_FF), D ** -0.5),
        'w3_dense': nrm(ks[23], (N_DENSE, D, D_FF), D ** -0.5),
        'w2_dense': nrm(ks[24], (N_DENSE, D_FF, D), D_FF ** -0.5),
        'w_router': nrm(ks[25], (N_MOE, D, N_EXPERTS), D ** -0.5),
        'b_router': nrm(ks[26], (N_MOE, N_EXPERTS), 0.01),
        'w1_moe': nrm(ks[27], (N_MOE, N_EXPERTS, D, D_FF), D ** -0.5),
        'w3_moe': nrm(ks[28], (N_MOE, N_EXPERTS, D, D_FF), D ** -0.5),
        'w2_moe': nrm(ks[29], (N_MOE, N_EXPERTS, D_FF, D), D_FF ** -0.5),
        'g_final': 1.0 + nrm(ks[30], (D,), 0.05),
    }


def reference(x, c, w_ada, b_ada, g_mix, w_in, b_forget, b_gate, lam_re, lam_im, log_dt,
              b_re, b_im, c_re, c_im, d_skip, w_glu, b_glu, w_proj_att, w_proj_ssm, w_out,
              g_ffn, w1_dense, w3_dense, w2_dense, w_router, b_router, w1_moe, w3_moe, w2_moe,
              g_final):
    bsz, seq, d = x.shape
    cond = jax.nn.silu(c)
    splits = [ATT_WIDTH, 2 * ATT_WIDTH, 3 * ATT_WIDTH, 3 * ATT_WIDTH + ATT_HEADS,
              3 * ATT_WIDTH + ATT_HEADS + SSM_WIDTH]
    for l in range(DEPTH):
        ada = (cond @ w_ada[l] + b_ada[l])[:, None, :]
        sh1, sc1, gt1, sh2, sc2, gt2 = jnp.split(ada, 6, axis=-1)

        h = _rmsnorm(x, g_mix[l]) * (1.0 + sc1) + sh1
        z = h @ w_in[l]
        q, k, v, fg, u, gates = jnp.split(z, splits, axis=-1)
        log_f = jax.nn.log_sigmoid((fg + b_forget[l]).astype(jnp.float32))
        hs = (bsz, seq, ATT_HEADS, ATT_HEAD_DIM)
        y_att = _forgetting_attention(q.reshape(hs), k.reshape(hs), v.reshape(hs), log_f) @ w_proj_att[l]
        y_ssm = _s5(u, lam_re[l], lam_im[l], log_dt[l], b_re[l], b_im[l], c_re[l], c_im[l],
                    d_skip[l], w_glu[l], b_glu[l]) @ w_proj_ssm[l]
        g_att, g_ssm = jnp.split(jax.nn.sigmoid(gates + b_gate[l]), 2, axis=-1)
        mixed = (g_att * y_att + g_ssm * y_ssm) @ w_out[l]
        x = x + gt1 * mixed

        h2 = _rmsnorm(x, g_ffn[l]) * (1.0 + sc2) + sh2
        if l % 2 == 0:
            m = l // 2
            f = _swiglu(h2, w1_dense[m], w3_dense[m], w2_dense[m])
        else:
            m = l // 2
            f = _moe(h2, w_router[m], b_router[m], w1_moe[m], w3_moe[m], w2_moe[m])
        x = x + gt2 * f
    return _rmsnorm(x, g_final)
```

```cpp
#include <hip/hip_runtime.h>
#include <hip/hip_bf16.h>
#include <cstdio>
#include <cstdint>
#include <cmath>

#ifndef DENSE_DOWN_FP8
#define DENSE_DOWN_FP8 0
#endif
#define GAS __attribute__((address_space(1)))
#define LAS __attribute__((address_space(3)))
typedef unsigned short bf16_t;
typedef short bf16x8 __attribute__((ext_vector_type(8)));
typedef float f32x4 __attribute__((ext_vector_type(4)));
typedef float f32x2 __attribute__((ext_vector_type(2)));
typedef unsigned u32x4 __attribute__((ext_vector_type(4)));
typedef unsigned u32x2 __attribute__((ext_vector_type(2)));
#define RLX_AGENT __ATOMIC_RELAXED, __HIP_MEMORY_SCOPE_AGENT
#define LDS_WAIT() asm volatile("s_waitcnt lgkmcnt(0)" ::: "memory")
#define VM_WAIT() asm volatile("s_waitcnt vmcnt(0)" ::: "memory")

constexpr int TOK = 32768, DMODEL = 1024, NBATCH = 16, SEQL = 2048, NLAYER = 2;
constexpr int DFF = 2816, NEXP = 8, NIN_SRC = 4104;
constexpr float EPS_RMS = 1e-6f;
constexpr float LOG2E = 1.4426950408889634f;
constexpr float C2Q = 0.125f * 1.4426950408889634f;

typedef __bf16 bf16x2_t __attribute__((ext_vector_type(2)));
__device__ __forceinline__ unsigned cvt_pk_bf16(float lo, float hi) { f32x2 v = {lo, hi}; bf16x2_t b = __builtin_convertvector(v, bf16x2_t); return __builtin_bit_cast(unsigned, b); }
__device__ __forceinline__ float bf_lo(unsigned w) { return __uint_as_float(w << 16); }
__device__ __forceinline__ float bf_hi(unsigned w) { return __uint_as_float(w & 0xffff0000u); }
__device__ __forceinline__ float fast_sigmoid(float x) { return __builtin_amdgcn_rcpf(1.0f + __builtin_amdgcn_exp2f(-x * LOG2E)); }
__device__ __forceinline__ f32x4 exp2_4(const f32x4& t) { return (f32x4){__builtin_amdgcn_exp2f(t[0]), __builtin_amdgcn_exp2f(t[1]), __builtin_amdgcn_exp2f(t[2]), __builtin_amdgcn_exp2f(t[3])}; }
__device__ __forceinline__ f32x4 rcp_4(const f32x4& d) { return (f32x4){__builtin_amdgcn_rcpf(d[0]), __builtin_amdgcn_rcpf(d[1]), __builtin_amdgcn_rcpf(d[2]), __builtin_amdgcn_rcpf(d[3])}; }
__device__ __forceinline__ f32x4 sigmoid_4(const f32x4& x) { return rcp_4(exp2_4(x * (-LOG2E)) + 1.0f); }
__device__ __forceinline__ f32x4 silu_mul_4(const f32x4& a, const f32x4& b) { return (a * b) * sigmoid_4(a); }
__device__ __forceinline__ float gelu_tanh(float x) { const float u = x + 0.044715f * x * x * x; return x * __builtin_amdgcn_rcpf(1.0f + __builtin_amdgcn_exp2f(-1.5957691216f * LOG2E * u)); }
__device__ __forceinline__ unsigned f2bf(float f) { unsigned u = __builtin_bit_cast(unsigned, f); return (u + 0x7fffu + ((u >> 16) & 1u)) >> 16; }
__device__ __forceinline__ unsigned pk2(float lo, float hi) { return f2bf(lo) | (f2bf(hi) << 16); }
template <int CTRL, int ROWMASK, int BANKMASK> __device__ __forceinline__ float dpp_f(float old, float v) { return __int_as_float(__builtin_amdgcn_update_dpp(__float_as_int(old), __float_as_int(v), CTRL, ROWMASK, BANKMASK, false)); }
__device__ __forceinline__ float wave_sum(float v) {
    v += dpp_f<0xB1, 0xF, 0xF>(0.f, v); v += dpp_f<0x4E, 0xF, 0xF>(0.f, v); v += dpp_f<0x141, 0xF, 0xF>(0.f, v); v += dpp_f<0x140, 0xF, 0xF>(0.f, v);
    v += dpp_f<0x142, 0xA, 0xF>(0.f, v); v += dpp_f<0x143, 0xC, 0xF>(0.f, v);
    return __int_as_float(__builtin_amdgcn_readlane(__float_as_int(v), 63));
}
__device__ __forceinline__ float wave_max_nonneg(float v) {
    v = fmaxf(v, dpp_f<0xB1, 0xF, 0xF>(0.f, v)); v = fmaxf(v, dpp_f<0x4E, 0xF, 0xF>(0.f, v)); v = fmaxf(v, dpp_f<0x141, 0xF, 0xF>(0.f, v)); v = fmaxf(v, dpp_f<0x140, 0xF, 0xF>(0.f, v));
    v = fmaxf(v, dpp_f<0x142, 0xA, 0xF>(0.f, v)); v = fmaxf(v, dpp_f<0x143, 0xC, 0xF>(0.f, v));
    return __int_as_float(__builtin_amdgcn_readlane(__float_as_int(v), 63));
}
__device__ __forceinline__ float xor16_sum(float v) { const auto r = __builtin_amdgcn_permlane16_swap(__float_as_int(v), __float_as_int(v), false, false); return __int_as_float(r[0]) + __int_as_float(r[1]); }
__device__ __forceinline__ float xor32_sum(float v) { const auto r = __builtin_amdgcn_permlane32_swap(__float_as_int(v), __float_as_int(v), false, false); return __int_as_float(r[0]) + __int_as_float(r[1]); }

__device__ __forceinline__ unsigned pack_i8(float a, float b, float c, float d) {
    const unsigned ua = __float_as_uint(a + 12582912.f), ub = __float_as_uint(b + 12582912.f), uc = __float_as_uint(c + 12582912.f), ud = __float_as_uint(d + 12582912.f);
    const unsigned ab = __builtin_amdgcn_perm(ub, ua, 0x0c0c0400u), cd = __builtin_amdgcn_perm(ud, uc, 0x0c0c0400u);
    return __builtin_amdgcn_perm(cd, ab, 0x05040100u);
}

namespace pg8 {
constexpr int BM = 256, BK = 64, HALF = 128, HTB = HALF * BK * 2, STAGE_BYTES = 8 * HTB, NXCD = 8, WGM = 8;
__host__ __device__ __forceinline__ int lds_byte(int r, int c) { const int st = (r >> 4) * 2 + (c >> 5), rr = r & 15, cc = c & 31, ob = rr * 64 + cc * 2; return st * 1024 + (ob ^ (((ob >> 9) & 1) << 5)); }
__host__ __device__ __forceinline__ void stage_rc(int b, int& R, int& C) { const int st = b / 1024, sb = b % 1024, swz = sb ^ (((sb >> 9) & 1) << 5); R = (st >> 1) * 16 + swz / 64; C = (st & 1) * 32 + (swz % 64) / 2; }
__host__ __device__ __forceinline__ int perm32(int rho) { const int n = rho >> 4, i = rho & 15; return 8 * (i >> 2) + 4 * n + (i & 3); }

typedef int v8i_t __attribute__((ext_vector_type(8)));
typedef int v4i_t __attribute__((ext_vector_type(4)));
__device__ __forceinline__ v8i_t cat8(const bf16x8& lo, const bf16x8& hi) { typedef int v4i_t __attribute__((ext_vector_type(4))); const v4i_t a = __builtin_bit_cast(v4i_t, lo), b = __builtin_bit_cast(v4i_t, hi); return (v8i_t){a[0], a[1], a[2], a[3], b[0], b[1], b[2], b[3]}; }
struct Unit { int pm, pn; };
struct TileOrder {
    int nM, nN, nwg, G, c;
    __device__ __forceinline__ void init(int nM_, int nN_, int G_, int c_) { nM = nM_; nN = nN_; nwg = nM * nN; G = G_; c = c_; }
    __device__ __forceinline__ bool next(int i, Unit& u) const {
        const long L = (long)i * G + c; if (L >= nwg) return false;
        int wgid = (int)L; { const int q = nwg / NXCD, r = nwg % NXCD, xcd = wgid % NXCD, off = wgid / NXCD; wgid = (xcd < r ? xcd * (q + 1) : r * (q + 1) + (xcd - r) * q) + off; }
        const int nig = WGM * nN, gid = wgid / nig, fm = gid * WGM, gsz = (nM - fm) < WGM ? (nM - fm) : WGM;
        u.pm = fm + ((wgid % nig) % gsz); u.pn = (wgid % nig) / gsz; return true;
    }
};

template <class Epi, class Prob, bool ALIGN_EPI>
__device__ __forceinline__ void gemm_phase(LAS unsigned char* lds, const Prob& S, const Epi& E) {
    int tid = threadIdx.x; asm volatile("" : "+v"(tid));
    const int wid = __builtin_amdgcn_readfirstlane(tid >> 6), lane = tid & 63, wr = wid >> 2, wc = wid & 3, fr = lane & 15, fq = lane >> 4;
    const int K = S.K, nt = K / BK, lda = S.lda, ldb = S.ldb;
    int Rr[2], Cc[2]; unsigned voffB[2];
#pragma unroll
    for (int i = 0; i < 2; ++i) { stage_rc(tid * 16 + i * 8192, Rr[i], Cc[i]); const int Rb = Epi::PERM ? ((Rr[i] & ~31) + perm32(Rr[i] & 31)) : Rr[i];
        voffB[i] = (unsigned)(Rb * ldb + Cc[i]) * 2u; }
    const size_t kstep = (size_t)(BK * 2);
    const size_t hstepA = (size_t)HALF * lda * 2, hstepB = (size_t)HALF * ldb * 2;
    const unsigned ldsw = (unsigned)wid * 1024u;
    const int aoff = lds_byte(wr * 64 + fr, fq * 8), boff = lds_byte(wc * 32 + fr, fq * 8);
#define PG8_SA(b, h) (((b) * 2 + (h)) * HTB)
#define PG8_SB(b, h) ((4 + (b) * 2 + (h)) * HTB)
#define PG8_STAGE(bufoff, gbase, voff) do { _Pragma("unroll") for (int _i = 0; _i < 2; ++_i) \
        __builtin_amdgcn_global_load_lds((const unsigned*)((const char*)(gbase) + (voff)[_i]), (LAS unsigned*)(lds + (bufoff) + ldsw + _i * 8192), 16, 0, 0); } while (0)
#define PG8_STAGE_A(bufoff, ptr, h, VO) do { if constexpr (Prob::GATHER) { PG8_STAGE(bufoff, ptr, VO[h]); } else { PG8_STAGE(bufoff, (ptr) + (h) * hstepA, VO[0]); } } while (0)
#define PG8_STAGE_B(bufoff, ptr, h) PG8_STAGE(bufoff, (ptr) + (h) * hstepB, voffB)
#define PG8_LDA(dst, b, h) do { _Pragma("unroll") for (int m = 0; m < 4; ++m) { if constexpr (Prob::FP8) { dst##8[m].lo = *(const LAS v4i_t*)(lds + PG8_SA(b, h) + aoff + m * 2048); dst##8[m].hi = *(const LAS v4i_t*)(lds + PG8_SA(b, h) + aoff + m * 2048 + 1024); } \
        else { _Pragma("unroll") for (int k = 0; k < 2; ++k) dst[m][k] = *(const LAS bf16x8*)(lds + PG8_SA(b, h) + aoff + m * 2048 + k * 1024); } } } while (0)
#define PG8_LDB(dst, b, h) do { _Pragma("unroll") for (int n = 0; n < 2; ++n) { if constexpr (Prob::FP8) { dst##8[n].lo = *(const LAS v4i_t*)(lds + PG8_SB(b, h) + boff + n * 2048); dst##8[n].hi = *(const LAS v4i_t*)(lds + PG8_SB(b, h) + boff + n * 2048 + 1024); } \
        else { _Pragma("unroll") for (int k = 0; k < 2; ++k) dst[n][k] = *(const LAS bf16x8*)(lds + PG8_SB(b, h) + boff + n * 2048 + k * 1024); } } } while (0)
#define PG8_MMA(ai, bj, At, Bt) do { __builtin_amdgcn_s_setprio(1); _Pragma("unroll") for (int m = 0; m < 4; ++m) _Pragma("unroll") for (int n = 0; n < 2; ++n) { \
        if constexpr (Prob::FP8) { asm volatile("v_mfma_scale_f32_16x16x128_f8f6f4 %0, %1, %2, %0, %3, %4 op_sel_hi:[0,0,0]" : "+v"(acc[ai][bj][m][n]) : "v"(Bt##8[n]), "v"(At##8[m]), "v"(sclB), "v"(sclA)); } \
        else if constexpr (Prob::I8) { _Pragma("unroll") for (int k = 0; k < 2; ++k) acc[ai][bj][m][n] = __builtin_bit_cast(f32x4, __builtin_amdgcn_mfma_i32_16x16x64_i8(__builtin_bit_cast(v4i_t, Bt[n][k]), __builtin_bit_cast(v4i_t, At[m][k]), __builtin_bit_cast(v4i_t, acc[ai][bj][m][n]), 0, 0, 0)); } \
        else { _Pragma("unroll") for (int k = 0; k < 2; ++k) acc[ai][bj][m][n] = __builtin_amdgcn_mfma_f32_16x16x32_bf16(Bt[n][k], At[m][k], acc[ai][bj][m][n], 0, 0, 0); } } __builtin_amdgcn_s_setprio(0); } while (0)
#define PG8_WAIT_V(n) asm volatile("s_waitcnt vmcnt(" #n ")" ::: "memory")
#define PG8_WAIT_L(n) asm volatile("s_waitcnt lgkmcnt(" #n ")" ::: "memory")
#define PG8_BAR __builtin_amdgcn_s_barrier()
#define PG8_SCHED __builtin_amdgcn_sched_barrier(0)
#define PG8_SETOFFS(VO, u) do { _Pragma("unroll") for (int _h = 0; _h < 2; ++_h) _Pragma("unroll") for (int _i = 0; _i < 2; ++_i) { \
        if constexpr (Prob::GATHER) VO[_h][_i] = (unsigned)(S.a_row(u, _h, Rr[_i]) * lda + Cc[_i]) * 2u; else VO[_h][_i] = (unsigned)(Rr[_i] * lda + Cc[_i]) * 2u; } } while (0)
    Unit cur, nxt; int ui = 0;
    if (!S.next(0, cur)) return;
    f32x4 acc[2][2][4][2];
#pragma unroll
    for (int a = 0; a < 2; ++a)
#pragma unroll
        for (int b = 0; b < 2; ++b)
#pragma unroll
            for (int m = 0; m < 4; ++m)
#pragma unroll
                for (int n = 0; n < 2; ++n) acc[a][b][m][n] = (f32x4){0.f, 0.f, 0.f, 0.f};
    bf16x8 At[4][2], B0[2][2], B1[2][2];
    v8i_t At8[4], B08[2], B18[2];
    int sclA = Prob::SCALE_A, sclB = Prob::SCALE_B; asm volatile("" : "+v"(sclA), "+v"(sclB));
    unsigned voA[2][2], voN[2][2];
    PG8_SETOFFS(voA, cur);
    const char* cA = S.a_base(cur); const char* cB = S.b_base(cur);
    if constexpr (Prob::STAGGER > 0) {
        if ((int)blockIdx.x & 1) { for (int s_ = 0; s_ < Prob::STAGGER; ++s_) __builtin_amdgcn_s_sleep(127); } }
    PG8_STAGE_B(PG8_SB(0, 0), cB, 0); PG8_STAGE_B(PG8_SB(0, 1), cB, 1); PG8_STAGE_A(PG8_SA(0, 0), cA, 0, voA); PG8_STAGE_A(PG8_SA(0, 1), cA, 1, voA);
    if (wr == 1) PG8_BAR;
    PG8_WAIT_V(2); PG8_BAR;
    PG8_STAGE_B(PG8_SB(1, 0), cB + kstep, 0); PG8_STAGE_A(PG8_SA(1, 0), cA + kstep, 0, voA); PG8_STAGE_B(PG8_SB(1, 1), cB + kstep, 1);
    PG8_WAIT_V(6); PG8_BAR;
    for (;;) {
        const bool has_next = S.next(ui + 1, nxt);
        const char* nA = cA; const char* nB = cB;
        if (has_next) { nA = S.a_base(nxt); nB = S.b_base(nxt); }
        if constexpr (Prob::GATHER) {
            if (has_next) { PG8_SETOFFS(voN, nxt); }
            else {
#pragma unroll
                for (int h = 0; h < 2; ++h)
#pragma unroll
                    for (int i = 0; i < 2; ++i) voN[h][i] = voA[h][i]; }
        }
        for (int t = 0; t < nt; t += 2) {
            const bool last = (t == nt - 2);
            const char* a1 = cA + (size_t)(t + 1) * kstep;
            const char* a2 = last ? nA : cA + (size_t)(t + 2) * kstep; const char* b2 = last ? nB : cB + (size_t)(t + 2) * kstep;
            const char* a3 = a2 + kstep; const char* b3 = b2 + kstep;
            unsigned v2[2][2];
#pragma unroll
            for (int h = 0; h < 2; ++h)
#pragma unroll
                for (int i = 0; i < 2; ++i) { if constexpr (Prob::GATHER) v2[h][i] = last ? voN[h][i] : voA[h][i]; else v2[h][i] = voA[h][i]; }
            PG8_LDB(B0, 0, 0); PG8_LDB(B1, 0, 1); PG8_SCHED; PG8_LDA(At, 0, 0); PG8_STAGE_A(PG8_SA(1, 1), a1, 1, voA);
            PG8_WAIT_V(8); PG8_WAIT_L(0); PG8_BAR; PG8_MMA(0, 0, At, B0); PG8_MMA(0, 1, At, B1); PG8_BAR; PG8_SCHED;
            PG8_LDA(At, 0, 1); PG8_STAGE_B(PG8_SB(0, 0), b2, 0); PG8_STAGE_B(PG8_SB(0, 1), b2, 1); PG8_STAGE_A(PG8_SA(0, 0), a2, 0, v2);
            PG8_WAIT_V(8); PG8_WAIT_L(0); PG8_BAR; PG8_MMA(1, 0, At, B0); PG8_MMA(1, 1, At, B1); PG8_BAR; PG8_SCHED;
            PG8_LDB(B0, 1, 0); PG8_LDB(B1, 1, 1); PG8_SCHED; PG8_LDA(At, 1, 0); PG8_STAGE_A(PG8_SA(0, 1), a2, 1, v2);
            PG8_WAIT_V(8); PG8_WAIT_L(0); PG8_BAR; PG8_MMA(0, 0, At, B0); PG8_MMA(0, 1, At, B1); PG8_BAR; PG8_SCHED;
            PG8_LDA(At, 1, 1); PG8_STAGE_B(PG8_SB(1, 0), b3, 0); PG8_STAGE_B(PG8_SB(1, 1), b3, 1); PG8_STAGE_A(PG8_SA(1, 0), a3, 0, v2);
            PG8_WAIT_V(8); PG8_WAIT_L(0); PG8_BAR; PG8_MMA(1, 0, At, B0); PG8_MMA(1, 1, At, B1); PG8_BAR; PG8_SCHED;
        }
        if constexpr (ALIGN_EPI) { if (wr == 0) PG8_BAR; }
        if constexpr (Prob::FP8) asm volatile("s_nop 15\n\ts_nop 15" ::: "memory");
        { int fr_ = fr, fq_ = fq; asm volatile("" : "+v"(fr_), "+v"(fq_));
          if constexpr (Epi::TWO_SEG) { if (S.is_mid(cur)) E.mid(acc, cur, wr, wc, fr_, fq_); else E(acc, cur, wr, wc, fr_, fq_); }
          else E(acc, cur, wr, wc, fr_, fq_);
        }
        if (!has_next) break;
        bool zero_acc = true; if constexpr (Epi::TWO_SEG) zero_acc = !S.is_mid(cur);
        if (zero_acc) {
#pragma unroll
        for (int a = 0; a < 2; ++a)
#pragma unroll
            for (int b = 0; b < 2; ++b)
#pragma unroll
                for (int m = 0; m < 4; ++m)
#pragma unroll
                    for (int n = 0; n < 2; ++n) acc[a][b][m][n] = (f32x4){0.f, 0.f, 0.f, 0.f};
        }
        cur = nxt; cA = nA; cB = nB; ++ui;
        if constexpr (Prob::GATHER) {
#pragma unroll
            for (int h = 0; h < 2; ++h)
#pragma unroll
                for (int i = 0; i < 2; ++i) voA[h][i] = voN[h][i]; }
        if constexpr (ALIGN_EPI) { if (wr == 1) PG8_BAR; }
    }
    PG8_WAIT_V(0);
    if constexpr (!ALIGN_EPI) { if (wr == 0) PG8_BAR; }
    PG8_BAR;
#undef PG8_SA
#undef PG8_SB
#undef PG8_STAGE
#undef PG8_STAGE_A
#undef PG8_STAGE_B
#undef PG8_LDA
#undef PG8_LDB
#undef PG8_MMA
#undef PG8_WAIT_V
#undef PG8_WAIT_L
#undef PG8_BAR
#undef PG8_SCHED
#undef PG8_SETOFFS
}
}

constexpr size_t MiB = 1u << 20;
constexpr size_t WS_CTL = 0, CTL_ZERO_BYTES = 1 * MiB;
constexpr size_t WS_ADA = 1 * MiB;
constexpr size_t WS_FL2 = 2 * MiB;
constexpr size_t WS_LOGF = 3 * MiB;
constexpr size_t WS_TOKE = 4 * MiB;
constexpr size_t WS_TOKW = 4 * MiB + 256 * 1024;
constexpr size_t WS_SORT = 5 * MiB;
constexpr size_t WS_A32 = 6 * MiB;
constexpr size_t WS_AU = 8 * MiB;
constexpr size_t WS_Y2 = 8 * MiB;
constexpr size_t WS_SLOC = 48 * MiB;
constexpr size_t WS_WIN = 64 * MiB;
constexpr size_t WS_WPA = 80 * MiB;
constexpr size_t WS_WPS = 82 * MiB;
constexpr size_t WS_WOUT = 84 * MiB;
constexpr size_t WS_WGLU = 88 * MiB;
constexpr size_t WS_TG = 89 * MiB;
constexpr size_t WS_WST = 129 * MiB;
constexpr size_t WS_WUPD = 145 * MiB;
constexpr size_t WS_WDND = 156 * MiB;
constexpr size_t WS_H = 162 * MiB;
constexpr size_t WS_Q = 226 * MiB;
constexpr size_t WS_K = 258 * MiB;
constexpr size_t WS_V = 290 * MiB;
constexpr size_t WS_MIX = 258 * MiB;
constexpr size_t WS_GATES = 322 * MiB;
constexpr size_t WS_Y = 450 * MiB;
constexpr size_t WS_HID = 226 * MiB;
constexpr size_t WS_WUPM = 64 * MiB;
constexpr size_t WS_WDNM = 484 * MiB;
constexpr size_t WS_END = 506 * MiB;
constexpr size_t WS_SL = WS_AU;
constexpr size_t WS_LS = WS_LOGF;
constexpr size_t WS_TMPX = WS_Q;
constexpr size_t WS_KTAB = 482 * MiB;
constexpr size_t WS_XB = WS_H;
constexpr size_t WS_H8 = WS_Y;
static_assert(WS_XB + (size_t)TOK * DMODEL * 2 <= WS_Q && WS_WDNM + (size_t)8 * 1024 * DFF <= WS_END && (size_t)8 * 5632 * 1024 <= (size_t)TOK * DMODEL * 4, "residual stream / fp8 MoE weights");
constexpr size_t WS_SA1 = 6 * MiB + 128 * 1024, WS_SA2 = 6 * MiB + 256 * 1024;
constexpr int CW_CMAX = 65536;
static_assert(WS_K - WS_Q == (size_t)TOK * 512 * 2 && WS_V - WS_K == (size_t)TOK * 512 * 2, "q|k|v contiguous");
static_assert(WS_HID + (size_t)TOK * DFF * 2 <= WS_Y && WS_HID + (size_t)135 * 256 * DFF <= WS_Y, "hidden buffers (dense bf16 / MoE fp8) end below Y");
constexpr int SLOT_CAP = 34816;
constexpr size_t SORT_ROWLIST = 0, SORT_SLOTW = 2 * SLOT_CAP * 4, SORT_PEXP = 4 * SLOT_CAP * 4, SORT_NP = SORT_PEXP + 2 * 136 * 4, SORT_CNT = SORT_NP + 64;
constexpr size_t SORT_PANEL = SORT_CNT + 256 * 16 * 4, SORT_NPC = SORT_PANEL + 3 * 136 * 4;
constexpr size_t SORT_PANELM = SORT_NPC + 64, SORT_NPM = SORT_PANELM + 144 * 4;
static_assert(SORT_NPM + 64 <= MiB, "sort tables");
constexpr int CW_BAR = 4096;

namespace pg8 {
struct ProbPlain {
    static constexpr bool FP8 = false; static constexpr int SCALE_A = 0, SCALE_B = 0;
    static constexpr bool GATHER = false; static constexpr int STAGGER = 0; static constexpr bool I8 = false;
    const bf16_t* A; const bf16_t* Bt; int K, lda, ldb; TileOrder ord;
    __device__ __forceinline__ bool next(int i, Unit& u) const { return ord.next(i, u); }
    __device__ __forceinline__ const char* a_base(const Unit& u) const { return (const char*)A + (size_t)u.pm * 256 * lda * 2; }
    __device__ __forceinline__ const char* b_base(const Unit& u) const { return (const char*)Bt + (size_t)u.pn * 256 * ldb * 2; }
    __device__ __forceinline__ int a_row(const Unit&, int, int) const { return 0; }
};
struct ProbPlain8 {
    static constexpr bool GATHER = false, FP8 = true; static constexpr int STAGGER = 0; static constexpr bool I8 = false; static constexpr int SCALE_A = 0x7F7F7F7F, SCALE_B = 0x79797979;
    const bf16_t* A; const bf16_t* Bt; int K, lda, ldb; TileOrder ord;
    __device__ __forceinline__ bool next(int i, Unit& u) const { return ord.next(i, u); }
    __device__ __forceinline__ const char* a_base(const Unit& u) const { return (const char*)A + (size_t)u.pm * 256 * lda * 2; }
    __device__ __forceinline__ const char* b_base(const Unit& u) const { return (const char*)Bt + (size_t)u.pn * 256 * ldb * 2; }
    __device__ __forceinline__ int a_row(const Unit&, int, int) const { return 0; }
};
struct ProbProj2 {
    static constexpr bool GATHER = false, FP8 = false; static constexpr int STAGGER = 0; static constexpr bool I8 = false; static constexpr int SCALE_A = 0, SCALE_B = 0;
    const bf16_t* A0; long dA; const bf16_t* B0; long dB; int K, lda, ldb; TileOrder ord;
    __device__ __forceinline__ bool next(int i, Unit& u) const { Unit t; if (!ord.next(i >> 1, t)) return false; u.pm = t.pm; u.pn = 2 * t.pn + (i & 1); return true; }
    __device__ __forceinline__ bool is_mid(const Unit& u) const { return (u.pn & 1) == 0; }
    __device__ __forceinline__ const char* a_base(const Unit& u) const { return (const char*)A0 + (long)(u.pn & 1) * dA + (size_t)u.pm * 256 * lda * 2; }
    __device__ __forceinline__ const char* b_base(const Unit& u) const { return (const char*)B0 + (long)(u.pn & 1) * dB + (size_t)(u.pn >> 1) * 256 * ldb * 2; }
    __device__ __forceinline__ int a_row(const Unit&, int, int) const { return 0; }
};
struct ProbPlainI8 {
    static constexpr bool GATHER = false, FP8 = false, I8 = true; static constexpr int STAGGER = 0, SCALE_A = 0, SCALE_B = 0;
    const bf16_t* A; const bf16_t* Bt; int K, lda, ldb; TileOrder ord;
    __device__ __forceinline__ bool next(int i, Unit& u) const { return ord.next(i, u); }
    __device__ __forceinline__ const char* a_base(const Unit& u) const { return (const char*)A + (size_t)u.pm * 256 * lda * 2; }
    __device__ __forceinline__ const char* b_base(const Unit& u) const { return (const char*)Bt + (size_t)u.pn * 256 * ldb * 2; }
    __device__ __forceinline__ int a_row(const Unit&, int, int) const { return 0; }
};
struct ProbUpI8 {
    static constexpr bool GATHER = true, FP8 = false, I8 = true; static constexpr int STAGGER = 0, SCALE_A = 0, SCALE_B = 0;
    const bf16_t* A; const bf16_t* Bt; const int* rowlist; const int* pexp; const int* panel; int K, lda, ldb; TileOrder ord;
    __device__ __forceinline__ bool next(int i, Unit& u) const { return ord.next(i, u); }
    __device__ __forceinline__ int desc(const Unit& u) const { return __builtin_amdgcn_readfirstlane(__hip_atomic_load(panel + u.pm, RLX_AGENT)); }
    __device__ __forceinline__ const char* a_base(const Unit&) const { return (const char*)A; }
    __device__ __forceinline__ const char* b_base(const Unit& u) const { return (const char*)Bt + (size_t)u.pn * 256 * ldb * 2; }
    __device__ __forceinline__ int a_row(const Unit& u, int h, int R) const { const int d = desc(u); const int r = __hip_atomic_load(rowlist + (d / 136) * SLOT_CAP + (d % 136) * 256 + h * 128 + R, RLX_AGENT); return r < 0 ? 0 : r; }
};
struct ProbS5b {
    static constexpr bool FP8 = false; static constexpr int SCALE_A = 0, SCALE_B = 0;
    static constexpr bool GATHER = false; static constexpr int STAGGER = 0; static constexpr bool I8 = false;
    const bf16_t* A; const bf16_t* Bt; int K, lda, ldb; TileOrder ord;
    __device__ __forceinline__ bool next(int i, Unit& u) const { return ord.next(i, u); }
    __device__ __forceinline__ const char* a_base(const Unit& u) const { return (const char*)A + (size_t)u.pm * 256 * lda * 2; }
    __device__ __forceinline__ const char* b_base(const Unit& u) const { return (const char*)Bt + (size_t)(u.pm >> 2) * 256 * ldb * 2; }
    __device__ __forceinline__ int a_row(const Unit&, int, int) const { return 0; }
};
struct ProbS5ad {
    static constexpr bool FP8 = false; static constexpr int SCALE_A = 0, SCALE_B = 0;
    static constexpr bool GATHER = false; static constexpr int STAGGER = 0; static constexpr bool I8 = false;
    const bf16_t* A; const bf16_t* Bt; int K, lda, ldb; TileOrder ord;
    __device__ __forceinline__ bool next(int i, Unit& u) const { return ord.next(i, u); }
    __device__ __forceinline__ const char* a_base(const Unit& u) const { return (const char*)A + (size_t)u.pm * 256 * lda * 2; }
    __device__ __forceinline__ const char* b_base(const Unit& u) const { return (const char*)Bt + ((size_t)(u.pm >> 2) * 512 + (size_t)u.pn * 256) * ldb * 2; }
    __device__ __forceinline__ int a_row(const Unit&, int, int) const { return 0; }
};
struct ProbUp {
    static constexpr bool FP8 = false; static constexpr int SCALE_A = 0, SCALE_B = 0;
    static constexpr bool GATHER = true; static constexpr int STAGGER = 0; static constexpr bool I8 = false;
    const bf16_t* A; const bf16_t* Bt; const int* rowlist; const int* pexp; const int* panel; int K, lda, ldb; TileOrder ord;
    __device__ __forceinline__ bool next(int i, Unit& u) const { return ord.next(i, u); }
    __device__ __forceinline__ int desc(const Unit& u) const { return __builtin_amdgcn_readfirstlane(__hip_atomic_load(panel + u.pm, RLX_AGENT)); }
    __device__ __forceinline__ const char* a_base(const Unit&) const { return (const char*)A; }
    __device__ __forceinline__ const char* b_base(const Unit& u) const { const int e = __builtin_amdgcn_readfirstlane(__hip_atomic_load(pexp + desc(u), RLX_AGENT));
        return (const char*)Bt + ((size_t)e * 5632 + (size_t)u.pn * 256) * ldb * 2; }
    __device__ __forceinline__ int a_row(const Unit& u, int h, int R) const { const int d = desc(u); const int r = __hip_atomic_load(rowlist + (d / 136) * SLOT_CAP + (d % 136) * 256 + h * 128 + R, RLX_AGENT); return r < 0 ? 0 : r; }
};
struct ProbUp8 {
    static constexpr bool GATHER = true, FP8 = true; static constexpr int STAGGER = 0; static constexpr bool I8 = false; static constexpr int SCALE_A = 0x7F7F7F7F, SCALE_B = 0x79797979;
    const bf16_t* A; const bf16_t* Bt; const int* rowlist; const int* pexp; const int* panel; int K, lda, ldb; TileOrder ord;
    __device__ __forceinline__ bool next(int i, Unit& u) const { return ord.next(i, u); }
    __device__ __forceinline__ int desc(const Unit& u) const { return __builtin_amdgcn_readfirstlane(__hip_atomic_load(panel + u.pm, RLX_AGENT)); }
    __device__ __forceinline__ const char* a_base(const Unit&) const { return (const char*)A; }
    __device__ __forceinline__ const char* b_base(const Unit& u) const { const int e = __builtin_amdgcn_readfirstlane(__hip_atomic_load(pexp + desc(u), RLX_AGENT));
        return (const char*)Bt + ((size_t)e * 5632 + (size_t)u.pn * 256) * ldb * 2; }
    __device__ __forceinline__ int a_row(const Unit& u, int h, int R) const { const int d = desc(u); const int r = __hip_atomic_load(rowlist + (d / 136) * SLOT_CAP + (d % 136) * 256 + h * 128 + R, RLX_AGENT); return r < 0 ? 0 : r; }
};
struct ProbDown8 {
    static constexpr bool GATHER = false, FP8 = true; static constexpr int STAGGER = 0; static constexpr bool I8 = false; static constexpr int SCALE_A = 0x7F7F7F7F, SCALE_B = 0x79797979;
    const bf16_t* A; const bf16_t* Bt; const int* pexp; const int* panel; int K, lda, ldb; TileOrder ord;
    __device__ __forceinline__ bool next(int i, Unit& u) const { return ord.next(i, u); }
    __device__ __forceinline__ const char* a_base(const Unit& u) const { return (const char*)A + (size_t)u.pm * 256 * lda * 2; }
    __device__ __forceinline__ const char* b_base(const Unit& u) const { const int d = __builtin_amdgcn_readfirstlane(__hip_atomic_load(panel + u.pm, RLX_AGENT));
        const int e = __builtin_amdgcn_readfirstlane(__hip_atomic_load(pexp + d, RLX_AGENT));
        return (const char*)Bt + ((size_t)e * 1024 + (size_t)u.pn * 256) * ldb * 2; }
    __device__ __forceinline__ int a_row(const Unit&, int, int) const { return 0; }
};
struct ProbDown {
    static constexpr bool FP8 = false; static constexpr int SCALE_A = 0, SCALE_B = 0;
    static constexpr bool GATHER = false; static constexpr int STAGGER = 0; static constexpr bool I8 = false;
    const bf16_t* A; const bf16_t* Bt; const int* pexp; const int* panel; int K, lda, ldb; TileOrder ord;
    __device__ __forceinline__ bool next(int i, Unit& u) const { return ord.next(i, u); }
    __device__ __forceinline__ const char* a_base(const Unit& u) const { return (const char*)A + ((size_t)u.pm * 256 * lda + (size_t)(u.pn >> 2) * K) * 2; }
    __device__ __forceinline__ const char* b_base(const Unit& u) const { const int d = __builtin_amdgcn_readfirstlane(__hip_atomic_load(panel + u.pm, RLX_AGENT));
        const int e = __builtin_amdgcn_readfirstlane(__hip_atomic_load(pexp + d, RLX_AGENT));
        return (const char*)Bt + (((size_t)e * 1024 + (size_t)(u.pn & 3) * 256) * ldb + (size_t)(u.pn >> 2) * K) * 2; }
    __device__ __forceinline__ int a_row(const Unit&, int, int) const { return 0; }
};

typedef f32x4 AccT[2][2][4][2];
__device__ __forceinline__ void st_nt16(void* p, const u32x4& v) { __builtin_nontemporal_store(v, (u32x4*)p); }
__device__ __forceinline__ void st_nt8(void* p, const u32x2& v) { __builtin_nontemporal_store(v, (u32x2*)p); }
__device__ __forceinline__ f32x4 i2f_4(const f32x4& a) { return (f32x4){(float)__float_as_int(a[0]), (float)__float_as_int(a[1]), (float)__float_as_int(a[2]), (float)__float_as_int(a[3])}; }
__device__ __forceinline__ u32x4 pack8(const f32x4& v0, const f32x4& v1) { u32x4 w; w.x = cvt_pk_bf16(v0[0], v0[1]); w.y = cvt_pk_bf16(v0[2], v0[3]); w.z = cvt_pk_bf16(v1[0], v1[1]); w.w = cvt_pk_bf16(v1[2], v1[3]); return w; }
__device__ __forceinline__ void unpack8(const u32x4& w, f32x4& v0, f32x4& v1) { v0 = (f32x4){bf_lo(w.x), bf_hi(w.x), bf_lo(w.y), bf_hi(w.y)}; v1 = (f32x4){bf_lo(w.z), bf_hi(w.z), bf_lo(w.w), bf_hi(w.w)}; }

template <bool I8> struct EpiIn {
    static constexpr bool PERM = true; static constexpr bool TWO_SEG = false;
    bf16_t* QKV; bf16_t* AU; bf16_t* Gates; const float* bgate; int pn_off; const float* sa; const unsigned* cmax;
    __device__ __forceinline__ void operator()(const AccT& acc, const Unit& u, int wr, int wc, int fr, int fq) const {
        const int pn = u.pn + pn_off, row0 = u.pm * BM + wr * 64 + fr, colw = wc * 32 + 8 * fq;
        float sar[2][4]; f32x4 sbv[2][2];
        if (I8) {
#pragma unroll
            for (int ai = 0; ai < 2; ++ai)
#pragma unroll
                for (int m = 0; m < 4; ++m) sar[ai][m] = sa[row0 + ai * HALF + m * 16] * (1.0f / 127.0f);
#pragma unroll
            for (int bj = 0; bj < 2; ++bj)
#pragma unroll
                for (int n = 0; n < 2; ++n) { const u32x4 cb = *(const u32x4*)(cmax + u.pn * 256 + bj * HALF + colw + 4 * n); sbv[bj][n] = (f32x4){__uint_as_float(cb.x), __uint_as_float(cb.y), __uint_as_float(cb.z), __uint_as_float(cb.w)}; }
        }
#define EPI_V(ai, bj, m, n) (I8 ? i2f_4(acc[ai][bj][m][n]) * (sbv[bj][n] * sar[ai][m]) : acc[ai][bj][m][n])
        if (pn < 6) {
            bf16_t* base = QKV + (size_t)(pn >> 1) * ((size_t)TOK * 512); const float sc = pn < 2 ? C2Q : 1.0f; const int c0 = (pn & 1) * 256 + colw;
#pragma unroll
            for (int ai = 0; ai < 2; ++ai)
#pragma unroll
                for (int m = 0; m < 4; ++m) { bf16_t* rowp = base + (size_t)(row0 + ai * HALF + m * 16) * 512 + c0;
#pragma unroll
                    for (int bj = 0; bj < 2; ++bj) { st_nt16(rowp + bj * HALF, pack8(EPI_V(ai, bj, m, 0) * sc, EPI_V(ai, bj, m, 1) * sc)); } }
        } else if (pn < 8) {
#pragma unroll
            for (int ai = 0; ai < 2; ++ai)
#pragma unroll
                for (int m = 0; m < 4; ++m) { const int row = row0 + ai * HALF + m * 16, b = row >> 11, t = row & 2047, chunk = t >> 5, s = t & 31;
#pragma unroll
                    for (int bj = 0; bj < 2; ++bj) { const int cu = (pn - 6) * 256 + bj * HALF + colw, g = cu >> 4, hh = cu & 15;
                        st_nt16(AU + ((size_t)(g * 1024 + b * 64 + chunk) * 640 + s * 16 + hh), pack8(EPI_V(ai, bj, m, 0), EPI_V(ai, bj, m, 1))); } }
        } else {
            const int c0 = (pn - 8) * 256 + colw;
            f32x4 bv[2][2];
#pragma unroll
            for (int bj = 0; bj < 2; ++bj)
#pragma unroll
                for (int n = 0; n < 2; ++n) bv[bj][n] = *(const f32x4*)(bgate + c0 + bj * HALF + 4 * n);
#pragma unroll
            for (int ai = 0; ai < 2; ++ai)
#pragma unroll
                for (int m = 0; m < 4; ++m) { bf16_t* rowp = Gates + (size_t)(row0 + ai * HALF + m * 16) * 2048 + c0;
#pragma unroll
                    for (int bj = 0; bj < 2; ++bj) { const f32x4 v0 = EPI_V(ai, bj, m, 0) + bv[bj][0], v1 = EPI_V(ai, bj, m, 1) + bv[bj][1];
                        st_nt16(rowp + bj * HALF, pack8(sigmoid_4(v0), sigmoid_4(v1))); } }
        }
#undef EPI_V
    }
};
struct EpiS5b {
    static constexpr bool PERM = false; static constexpr bool TWO_SEG = false;
    float* Sloc;
    __device__ __forceinline__ void operator()(const AccT& acc, const Unit& u, int wr, int wc, int fr, int fq) const {
        const int row0 = u.pm * BM + wr * 64 + fr;
#pragma unroll
        for (int ai = 0; ai < 2; ++ai)
#pragma unroll
            for (int m = 0; m < 4; ++m) { float* rowp = Sloc + (size_t)(row0 + ai * HALF + m * 16) * 128 + wc * 32 + 4 * fq;
#pragma unroll
                for (int n = 0; n < 2; ++n) *(f32x4*)(rowp + 16 * n) = acc[ai][0][m][n]; }
    }
};
struct EpiS5ad {
    static constexpr bool PERM = true; static constexpr bool TWO_SEG = false;
    const bf16_t* AU; bf16_t* Y; const float* dskip;
    __device__ __forceinline__ void operator()(const AccT& acc, const Unit& u, int wr, int wc, int fr, int fq) const {
        const int g = u.pm >> 2, rg0 = (u.pm & 3) * BM + wr * 64 + fr, ho = 8 * (fq & 1);
        const f32x4 d0 = *(const f32x4*)(dskip + g * 16 + ho), d1 = *(const f32x4*)(dskip + g * 16 + ho + 4);
        u32x4 uw[2][4][2];
#pragma unroll
        for (int ai = 0; ai < 2; ++ai)
#pragma unroll
            for (int m = 0; m < 4; ++m)
#pragma unroll
                for (int bj = 0; bj < 2; ++bj) { const int r = rg0 + ai * HALF + m * 16, c = u.pn * 256 + bj * HALF + wc * 32 + 8 * fq; uw[ai][m][bj] = *(const u32x4*)(AU + ((size_t)(g * 1024 + r) * 640 + c)); }
#pragma unroll
        for (int ai = 0; ai < 2; ++ai)
#pragma unroll
            for (int m = 0; m < 4; ++m) { const int r = rg0 + ai * HALF + m * 16, b = r >> 6, chunk = r & 63;
#pragma unroll
                for (int bj = 0; bj < 2; ++bj) { const int c = u.pn * 256 + bj * HALF + wc * 32 + 8 * fq, tl = c >> 4;
                    f32x4 u0, u1; unpack8(uw[ai][m][bj], u0, u1);
                    f32x4 v0 = acc[ai][bj][m][0] + d0 * u0, v1 = acc[ai][bj][m][1] + d1 * u1;
#pragma unroll
                    for (int j = 0; j < 4; ++j) { v0[j] = gelu_tanh(v0[j]); v1[j] = gelu_tanh(v1[j]); }
                    const int token = b * 2048 + chunk * 32 + tl;
                    st_nt16(Y + (size_t)token * 512 + g * 16 + ho, pack8(v0, v1)); } }
    }
};
struct EpiGlu {
    static constexpr bool PERM = true; static constexpr bool TWO_SEG = false;
    const bf16_t* Y; bf16_t* Y2; const float* bglu;
    __device__ __forceinline__ void operator()(const AccT& acc, const Unit& u, int wr, int wc, int fr, int fq) const {
        const int row0 = u.pm * BM + wr * 64 + fr, c0 = u.pn * 256 + wc * 32 + 8 * fq;
        f32x4 bv[2][2];
#pragma unroll
        for (int bj = 0; bj < 2; ++bj)
#pragma unroll
            for (int n = 0; n < 2; ++n) bv[bj][n] = *(const f32x4*)(bglu + c0 + bj * HALF + 4 * n);
        u32x4 yw[2][4][2];
#pragma unroll
        for (int ai = 0; ai < 2; ++ai)
#pragma unroll
            for (int m = 0; m < 4; ++m)
#pragma unroll
                for (int bj = 0; bj < 2; ++bj) yw[ai][m][bj] = *(const u32x4*)(Y + (size_t)(row0 + ai * HALF + m * 16) * 512 + c0 + bj * HALF);
#pragma unroll
        for (int ai = 0; ai < 2; ++ai)
#pragma unroll
            for (int m = 0; m < 4; ++m) { const size_t ro = (size_t)(row0 + ai * HALF + m * 16) * 512 + c0;
#pragma unroll
                for (int bj = 0; bj < 2; ++bj) { f32x4 y0, y1; unpack8(yw[ai][m][bj], y0, y1);
                    f32x4 v0 = acc[ai][bj][m][0] + bv[bj][0], v1 = acc[ai][bj][m][1] + bv[bj][1];
#pragma unroll
                    for (int j = 0; j < 4; ++j) { v0[j] = y0[j] * fast_sigmoid(v0[j]); v1[j] = y1[j] * fast_sigmoid(v1[j]); }
                    st_nt16(Y2 + ro + bj * HALF, pack8(v0, v1)); } }
    }
};
template <int MODE> struct EpiProj {
    static constexpr bool PERM = true; static constexpr bool TWO_SEG = false;
    const bf16_t* Gates; const bf16_t* Tin; bf16_t* Out;
    __device__ __forceinline__ void operator()(const AccT& acc, const Unit& u, int wr, int wc, int fr, int fq) const {
        const int row0 = u.pm * BM + wr * 64 + fr, c0 = u.pn * 256 + wc * 32 + 8 * fq;
#pragma unroll
        for (int ai = 0; ai < 2; ++ai) {
            u32x4 gw[4][2], tw[4][2];
#pragma unroll
            for (int m = 0; m < 4; ++m)
#pragma unroll
                for (int bj = 0; bj < 2; ++bj) { const size_t row = (size_t)(row0 + ai * HALF + m * 16); const int c = c0 + bj * HALF;
                    gw[m][bj] = *(const u32x4*)(Gates + row * 2048 + MODE * 1024 + c); if (MODE == 1) tw[m][bj] = *(const u32x4*)(Tin + row * 1024 + c); }
#pragma unroll
            for (int m = 0; m < 4; ++m) { const size_t row = (size_t)(row0 + ai * HALF + m * 16);
#pragma unroll
                for (int bj = 0; bj < 2; ++bj) { const int c = c0 + bj * HALF; f32x4 g0, g1; unpack8(gw[m][bj], g0, g1);
                    f32x4 v0 = acc[ai][bj][m][0] * g0, v1 = acc[ai][bj][m][1] * g1;
                    if (MODE == 1) { f32x4 t0, t1; unpack8(tw[m][bj], t0, t1); v0 += t0; v1 += t1; }
                    *(u32x4*)(Out + row * 1024 + c) = pack8(v0, v1); } }
        }
    }
};
struct EpiProj2 {
    static constexpr bool PERM = true, TWO_SEG = true;
    const bf16_t* Gates; bf16_t* Out;
    __device__ __forceinline__ void mid(AccT& acc, const Unit& u, int wr, int wc, int fr, int fq) const {
        const int row0 = u.pm * BM + wr * 64 + fr, c0 = (u.pn >> 1) * 256 + wc * 32 + 8 * fq;
#pragma unroll
        for (int ai = 0; ai < 2; ++ai) {
            u32x4 ga[4][2], gs[4][2];
#pragma unroll
            for (int m = 0; m < 4; ++m)
#pragma unroll
                for (int bj = 0; bj < 2; ++bj) { const size_t ro = (size_t)(row0 + ai * HALF + m * 16) * 2048 + c0 + bj * HALF; ga[m][bj] = *(const u32x4*)(Gates + ro); gs[m][bj] = *(const u32x4*)(Gates + ro + 1024); }
#pragma unroll
            for (int m = 0; m < 4; ++m)
#pragma unroll
                for (int bj = 0; bj < 2; ++bj) { f32x4 a0, a1, s0, s1; unpack8(ga[m][bj], a0, a1); unpack8(gs[m][bj], s0, s1);
#pragma unroll
                    for (int j = 0; j < 4; ++j) { acc[ai][bj][m][0][j] *= a0[j] * __builtin_amdgcn_rcpf(fmaxf(s0[j], 1e-30f)); acc[ai][bj][m][1][j] *= a1[j] * __builtin_amdgcn_rcpf(fmaxf(s1[j], 1e-30f)); } }
        }
    }
    __device__ __forceinline__ void operator()(const AccT& acc, const Unit& u, int wr, int wc, int fr, int fq) const {
        const int row0 = u.pm * BM + wr * 64 + fr, c0 = (u.pn >> 1) * 256 + wc * 32 + 8 * fq;
#pragma unroll
        for (int ai = 0; ai < 2; ++ai) {
            u32x4 gs[4][2];
#pragma unroll
            for (int m = 0; m < 4; ++m)
#pragma unroll
                for (int bj = 0; bj < 2; ++bj) gs[m][bj] = *(const u32x4*)(Gates + (size_t)(row0 + ai * HALF + m * 16) * 2048 + 1024 + c0 + bj * HALF);
#pragma unroll
            for (int m = 0; m < 4; ++m)
#pragma unroll
                for (int bj = 0; bj < 2; ++bj) { f32x4 s0, s1; unpack8(gs[m][bj], s0, s1);
                    st_nt16(Out + (size_t)(row0 + ai * HALF + m * 16) * 1024 + c0 + bj * HALF, pack8(acc[ai][bj][m][0] * s0, acc[ai][bj][m][1] * s1)); }
        }
    }
};
template <bool IN_F32> struct EpiOut {
    static constexpr bool PERM = true; static constexpr bool TWO_SEG = false;
    const float* xin; bf16_t* xb; const float* gate; float mul;
    __device__ __forceinline__ void operator()(const AccT& acc, const Unit& u, int wr, int wc, int fr, int fq) const {
        const int row0 = u.pm * BM + wr * 64 + fr, c0 = u.pn * 256 + wc * 32 + 8 * fq; const int b = (u.pm * BM) >> 11;
        f32x4 gv[2][2];
#pragma unroll
        for (int bj = 0; bj < 2; ++bj)
#pragma unroll
            for (int n = 0; n < 2; ++n) gv[bj][n] = *(const f32x4*)(gate + (size_t)b * 6144 + c0 + bj * HALF + 4 * n) * mul;
#pragma unroll
        for (int ai = 0; ai < 2; ++ai) {
            f32x4 xv[4][2][2]; u32x4 xw[4][2];
#pragma unroll
            for (int m = 0; m < 4; ++m)
#pragma unroll
                for (int bj = 0; bj < 2; ++bj) { const size_t off = (size_t)(row0 + ai * HALF + m * 16) * 1024 + c0 + bj * HALF;
                    if (IN_F32) { xv[m][bj][0] = *(const f32x4*)(xin + off); xv[m][bj][1] = *(const f32x4*)(xin + off + 4); } else xw[m][bj] = *(const u32x4*)(xb + off); }
#pragma unroll
            for (int m = 0; m < 4; ++m)
#pragma unroll
                for (int bj = 0; bj < 2; ++bj) { const size_t off = (size_t)(row0 + ai * HALF + m * 16) * 1024 + c0 + bj * HALF;
                    f32x4 x0, x1; if (IN_F32) { x0 = xv[m][bj][0]; x1 = xv[m][bj][1]; } else unpack8(xw[m][bj], x0, x1);
                    st_nt16(xb + off, pack8(x0 + gv[bj][0] * acc[ai][bj][m][0], x1 + gv[bj][1] * acc[ai][bj][m][1])); }
        }
    }
};
template <bool F8, bool I8> struct EpiUp {
    static constexpr bool PERM = true; static constexpr bool TWO_SEG = false;
    bf16_t* Hid; const float* sa; const unsigned* cmax;
    __device__ __forceinline__ void operator()(const AccT& acc, const Unit& u, int wr, int wc, int fr, int fq) const {
        const int row0 = u.pm * BM + wr * 64 + fr, c0 = u.pn * 128 + wc * 32 + 8 * fq;
        f32x4 sbv[2][2];
        if (I8) {
#pragma unroll
            for (int bj = 0; bj < 2; ++bj)
#pragma unroll
                for (int n = 0; n < 2; ++n) { const u32x4 cb = *(const u32x4*)(cmax + u.pn * 256 + bj * HALF + wc * 32 + 8 * fq + 4 * n); sbv[bj][n] = (f32x4){__uint_as_float(cb.x), __uint_as_float(cb.y), __uint_as_float(cb.z), __uint_as_float(cb.w)}; }
        }
#pragma unroll
        for (int ai = 0; ai < 2; ++ai)
#pragma unroll
            for (int m = 0; m < 4; ++m) { f32x4 v0 = acc[ai][0][m][0], v1 = acc[ai][0][m][1]; f32x4 w0 = acc[ai][1][m][0], w1 = acc[ai][1][m][1];
                if (I8) { const float s = sa[row0 + ai * HALF + m * 16] * (1.0f / 127.0f);
                    v0 = i2f_4(v0) * (sbv[0][0] * s); v1 = i2f_4(v1) * (sbv[0][1] * s); w0 = i2f_4(w0) * (sbv[1][0] * s); w1 = i2f_4(w1) * (sbv[1][1] * s); }
                v0 = silu_mul_4(v0, w0); v1 = silu_mul_4(v1, w1);
                if (!F8) { st_nt16(Hid + (size_t)(row0 + ai * HALF + m * 16) * DFF + c0, pack8(v0, v1)); continue; }
                int p0 = 0, p1 = 0; p0 = __builtin_amdgcn_cvt_pk_fp8_f32(v0[0], v0[1], p0, false); p0 = __builtin_amdgcn_cvt_pk_fp8_f32(v0[2], v0[3], p0, true);
                p1 = __builtin_amdgcn_cvt_pk_fp8_f32(v1[0], v1[1], p1, false); p1 = __builtin_amdgcn_cvt_pk_fp8_f32(v1[2], v1[3], p1, true);
                st_nt8((unsigned char*)Hid + (size_t)(row0 + ai * HALF + m * 16) * DFF + c0, (u32x2){(unsigned)p0, (unsigned)p1}); }
    }
};
struct EpiDown {
    static constexpr bool PERM = true; static constexpr bool TWO_SEG = false;
    bf16_t* xb; const float* gate; const int* rowlist; const float* slotw; const int* panel; float mul;
    __device__ __forceinline__ void operator()(const AccT& acc, const Unit& u, int wr, int wc, int fr, int fq) const {
        const int d = __builtin_amdgcn_readfirstlane(__hip_atomic_load(panel + u.pm, RLX_AGENT));
        const int ls0 = (d / 136) * SLOT_CAP + (d % 136) * 256 + wr * 64 + fr, c0 = (u.pn & 3) * 256 + wc * 32 + 8 * fq;
        int tok[2][4]; float wv[2][4];
#pragma unroll
        for (int ai = 0; ai < 2; ++ai)
#pragma unroll
            for (int m = 0; m < 4; ++m) { const int ls = ls0 + ai * HALF + m * 16; tok[ai][m] = __hip_atomic_load(rowlist + ls, RLX_AGENT); wv[ai][m] = __hip_atomic_load(slotw + ls, RLX_AGENT) * mul; }
#pragma unroll
        for (int ai = 0; ai < 2; ++ai)
#pragma unroll
            for (int mp = 0; mp < 2; ++mp) {
                u32x4 xw[2][2]; f32x4 gv[2][2][2];
#pragma unroll
                for (int mm = 0; mm < 2; ++mm) { const int m = 2 * mp + mm; const int token = tok[ai][m] < 0 ? 0 : tok[ai][m]; const int b = token >> 11;
#pragma unroll
                    for (int bj = 0; bj < 2; ++bj) { xw[mm][bj] = *(const u32x4*)(xb + (size_t)token * 1024 + c0 + bj * HALF);
#pragma unroll
                        for (int n = 0; n < 2; ++n) gv[mm][bj][n] = *(const f32x4*)(gate + (size_t)b * 6144 + c0 + bj * HALF + 4 * n); } }
#pragma unroll
                for (int mm = 0; mm < 2; ++mm) { const int m = 2 * mp + mm; const int token = tok[ai][m];
                    if (token >= 0) {
#pragma unroll
                        for (int bj = 0; bj < 2; ++bj) { f32x4 x0, x1; unpack8(xw[mm][bj], x0, x1);
                            x0 += (gv[mm][bj][0] * wv[ai][m]) * acc[ai][bj][m][0]; x1 += (gv[mm][bj][1] * wv[ai][m]) * acc[ai][bj][m][1];
                            st_nt16(xb + (size_t)token * 1024 + c0 + bj * HALF, pack8(x0, x1)); } } }
            }
    }
};
struct EpiSlab {
    static constexpr bool PERM = false; static constexpr bool TWO_SEG = false;
    float* slab;
    __device__ __forceinline__ void operator()(const AccT& acc, const Unit& u, int wr, int wc, int fr, int fq) const {
        float* base = slab + (size_t)(u.pm * BM + wr * 64 + fr) * 1024 + u.pn * 256 + wc * 32 + 4 * fq;
#pragma unroll
        for (int ai = 0; ai < 2; ++ai)
#pragma unroll
            for (int m = 0; m < 4; ++m)
#pragma unroll
                for (int bj = 0; bj < 2; ++bj)
#pragma unroll
                    for (int n = 0; n < 2; ++n) *(f32x4*)(base + (size_t)(ai * HALF + m * 16) * 1024 + bj * HALF + 16 * n) = acc[ai][bj][m][n];
    }
};
}
namespace attn_body {
using bf16=__hip_bfloat16;
using s16x4=__attribute__((ext_vector_type(4)))short;
using f32x16=__attribute__((ext_vector_type(16)))float;
constexpr int BATCH=16,NHEAD=8,SEQ=2048,D=64,DM=NHEAD*D;
constexpr int NW=8,QBLK=32,QB=QBLK*NW,KVBLK=64,NQB=SEQ/QB;
constexpr int ATTN_PITCH=DM, ATTN_UNIT_ROWS=QB;
typedef float f32x4v __attribute__((ext_vector_type(4)));
__device__ __forceinline__ int crow(int r,int hi){return (r&3)+8*(r>>2)+4*hi;}
#define SBAR() __builtin_amdgcn_sched_barrier(0)
__device__ __forceinline__ void cmask(f32x16&p0,f32x16&p1,int jb,int qrel,int hi){
  const float NEG=-INFINITY; int kb=64*jb+4*hi;
  #pragma unroll
  for(int r=0;r<16;++r){int kv=kb+(r&3)+8*(r>>2); if(kv>qrel)p0[r]=NEG; if(kv+32>qrel)p1[r]=NEG;}
}

constexpr int NSLOT=3, SLOTB=8192;
constexpr int LDS_K=0, LDS_V=NSLOT*SLOTB, LDS_WS=2*NSLOT*SLOTB, LDS_OST=LDS_WS+NW*64*4, LDS_F=LDS_OST+NW*4096, LDS_BYTES=LDS_F+SEQ*4;
constexpr float C2=0.125f*1.4426950408889634f;
__device__ __forceinline__ void glds16(const void*gsrc,unsigned lds_dst){unsigned keep;
  asm volatile("s_mov_b32 %0, m0\n\ts_mov_b32 m0, %2\n\ts_nop 0\n\tglobal_load_lds_dwordx4 %1, off\n\ts_mov_b32 m0, %0":"=&s"(keep):"v"(gsrc),"s"(lds_dst):"memory");}
__device__ __forceinline__ float max3f(float a,float b,float c){float r;asm("v_max3_f32 %0, %1, %2, %3":"=v"(r):"v"(a),"v"(b),"v"(c));return r;}
__device__ __forceinline__ float max2f(float a,float b){float r;asm("v_max_f32_e32 %0, %1, %2":"=v"(r):"v"(a),"v"(b));return r;}
__device__ __forceinline__ float fadd_s(float a,float b){float r;asm("v_add_f32_e32 %0, %1, %2":"=v"(r):"v"(a),"v"(b));return r;}
__device__ __forceinline__ float fsub_s(float a,float b){float r;asm("v_sub_f32_e32 %0, %1, %2":"=v"(r):"v"(a),"v"(b));return r;}
typedef float f32x2_t __attribute__((ext_vector_type(2))); typedef __bf16 bf16x2_t __attribute__((ext_vector_type(2)));
__device__ __forceinline__ unsigned cvtpk_s(float lo,float hi){f32x2_t v={lo,hi};bf16x2_t b=__builtin_convertvector(v,bf16x2_t);return __builtin_bit_cast(unsigned,b);}
#define WAIT_BAR(N) asm volatile("s_waitcnt vmcnt(" #N ") lgkmcnt(0)\n\ts_barrier":::"memory")

__device__ __forceinline__ void qkt(f32x16&p0,f32x16&p1,const char*Kslot,const bf16x8*qr,int r32,int hi){
  const char*kb=Kslot+hi*1024+r32*16;
  #pragma unroll
  for(int d0=0;d0<4;++d0){
    const bf16x8 b0=*reinterpret_cast<const bf16x8*>(kb+d0*2048);
    const bf16x8 b1=*reinterpret_cast<const bf16x8*>(kb+d0*2048+512);
    p0=__builtin_amdgcn_mfma_f32_32x32x16_bf16(b0,qr[d0],p0,0,0,0);p1=__builtin_amdgcn_mfma_f32_32x32x16_bf16(b1,qr[d0],p1,0,0,0);}
}
typedef __attribute__((address_space(3))) const char* lds_cptr;
typedef short v4i16_t __attribute__((ext_vector_type(4)));
__device__ __forceinline__ void kload8(bf16x8*kf,lds_cptr kp){
  kf[0]=*(const __attribute__((address_space(3))) bf16x8*)(kp);      kf[1]=*(const __attribute__((address_space(3))) bf16x8*)(kp+512);
  kf[2]=*(const __attribute__((address_space(3))) bf16x8*)(kp+2048); kf[3]=*(const __attribute__((address_space(3))) bf16x8*)(kp+2560);
  kf[4]=*(const __attribute__((address_space(3))) bf16x8*)(kp+4096); kf[5]=*(const __attribute__((address_space(3))) bf16x8*)(kp+4608);
  kf[6]=*(const __attribute__((address_space(3))) bf16x8*)(kp+6144); kf[7]=*(const __attribute__((address_space(3))) bf16x8*)(kp+6656);
}
__device__ __forceinline__ void kload2(bf16x8*kf,lds_cptr kp,int j){ kf[2*j]=*(const __attribute__((address_space(3))) bf16x8*)(kp+j*2048); kf[2*j+1]=*(const __attribute__((address_space(3))) bf16x8*)(kp+j*2048+512); }
__device__ __forceinline__ s16x4 vtr(lds_cptr p){ return __builtin_bit_cast(s16x4,__builtin_amdgcn_ds_read_tr16_b64_v4i16((__attribute__((address_space(3))) v4i16_t*)p)); }
__device__ __forceinline__ float rowmax(const f32x16&p0,const f32x16&p1){
  float a=max3f(p0[0],p0[1],p1[0]),b=max3f(p0[2],p0[3],p1[1]);a=max3f(a,p1[2],p1[3]);
  #pragma unroll
  for(int r=4;r<16;r+=4){a=max3f(a,p0[r],p0[r+1]);b=max3f(b,p0[r+2],p0[r+3]);a=max3f(a,p1[r],p1[r+1]);b=max3f(b,p1[r+2],p1[r+3]);}
  const float m=max2f(a,b);
  auto rr=__builtin_amdgcn_permlane32_swap(__float_as_uint(m),__float_as_uint(m),false,false);
  return max2f(__uint_as_float(rr[0]),__uint_as_float(rr[1]));
}
__device__ __forceinline__ void pv(f32x16*o,int vb,bf16x8 pa0,bf16x8 pa1,bf16x8 pa2,bf16x8 pa3){
  #pragma unroll
  for(int d0=0;d0<2;++d0){s16x4 lo[4],hi[4];
    #pragma unroll
    for(int ks=0;ks<4;++ks){
      asm volatile("ds_read_b64_tr_b16 %0,%1 offset:%c2":"=&v"(lo[ks]):"v"(vb),"i"(d0*4096+ks*1024):"memory");
      asm volatile("ds_read_b64_tr_b16 %0,%1 offset:%c2":"=&v"(hi[ks]):"v"(vb),"i"(d0*4096+ks*1024+512):"memory");}
    asm volatile("s_waitcnt lgkmcnt(0)":::"memory");SBAR();
    #define PK(k) (bf16x8){lo[k][0],lo[k][1],lo[k][2],lo[k][3],hi[k][0],hi[k][1],hi[k][2],hi[k][3]}
    o[d0]=__builtin_amdgcn_mfma_f32_32x32x16_bf16(pa0,PK(0),o[d0],0,0,0);
    o[d0]=__builtin_amdgcn_mfma_f32_32x32x16_bf16(pa1,PK(1),o[d0],0,0,0);
    o[d0]=__builtin_amdgcn_mfma_f32_32x32x16_bf16(pa2,PK(2),o[d0],0,0,0);
    o[d0]=__builtin_amdgcn_mfma_f32_32x32x16_bf16(pa3,PK(3),o[d0],0,0,0);
    #undef PK
  }
}

typedef __attribute__((address_space(3))) const f32x4v* lds_f4ptr;
__device__ __forceinline__ void binit1(f32x16&c,lds_f4ptr fp,float nq){
  #pragma unroll
  for(int g=0;g<4;++g){ const f32x4v a=fp[2*g];
    #pragma unroll
    for(int j=0;j<4;++j){ c[4*g+j]=nq-a[j]; } }
}
__device__ __forceinline__ void binit(f32x16&c0,f32x16&c1,lds_f4ptr fp,float nq){ binit1(c0,fp,nq); binit1(c1,fp+8,nq); }
#ifndef ATTN_STORE16
#define ATTN_STORE16(p,v) (*(u32x4*)(p)=(v))
#endif
template<int THRL> __device__ __forceinline__ void attn_unit(int b,int h,int qb,const bf16*Q,const bf16*__restrict__ K,const bf16*__restrict__ V,bf16*O,const float*Fl2,char*shm){
  int tid=threadIdx.x; asm volatile("":"+v"(tid)); const int lane=tid&63,r32=lane&31,hi=lane>>5; const int wid=__builtin_amdgcn_readfirstlane(tid>>6);
  const long rowbase=(long)b*SEQ; const int q0=qb*QB;
  const bf16*Qw=Q+(rowbase+q0+wid*QBLK)*DM+h*D;
  const bf16*Kh=K+rowbase*DM+h*D,*Vh=V+rowbase*DM+h*D;
  const unsigned lds0=(unsigned)(uintptr_t)shm;
  float*wsf=(float*)(shm+LDS_WS)+wid*64;
  const bf16*ksrc=Kh+(long)lane*DM+wid*8;
  const bf16*vsrc=Vh+(long)(16*(wid&3)+(lane>>2))*DM+(wid>>2)*32+(lane&3)*8;
  const unsigned kdst=lds0+LDS_K+wid*1024, vdst=lds0+LDS_V+wid*1024;
  #define DMA_K(t,slot) glds16(ksrc+(long)(t)*KVBLK*DM,(unsigned)__builtin_amdgcn_readfirstlane(kdst+(slot)))
  #define DMA_V(t,slot) glds16(vsrc+(long)(t)*KVBLK*DM,(unsigned)__builtin_amdgcn_readfirstlane(vdst+(slot)))
  const int vb0=(int)(lds0+LDS_V)+((lane>>4)&1)*32+(lane&3)*8+(4*hi+((lane&15)>>2))*64;
  const char*Kbase=shm+LDS_K; bf16x8 kf[8];
  const lds_cptr shm3=(lds_cptr)shm; const lds_cptr kp0=shm3+LDS_K+hi*1024+r32*16; const lds_cptr vp0=shm3+LDS_V+((lane>>4)&1)*32+(lane&3)*8+(4*hi+((lane&15)>>2))*64;
  const int NT=(q0+QB)/KVBLK;
  { const float*Fg=Fl2+(long)(b*NHEAD+h)*SEQ; const int i4=tid*4;
    if(i4<q0+QB){ const f32x4v fv=*reinterpret_cast<const f32x4v*>(Fg+i4); *(__attribute__((address_space(3))) f32x4v*)((__attribute__((address_space(3))) char*)shm3+LDS_F+i4*4)=fv; } }
  const lds_f4ptr fbase=(lds_f4ptr)(shm3+LDS_F+16*hi);
  DMA_K(0,0);DMA_V(0,0);DMA_K(1,SLOTB);
  bf16x8 qr[4];
  #pragma unroll
  for(int d0=0;d0<4;++d0)qr[d0]=*reinterpret_cast<const bf16x8*>(&Qw[(long)r32*DM+d0*16+hi*8]);
  float mhat=0.f,l_reg=0.f,nq=0.f,fq_l2=0.f;f32x16 o[2];o[0]=f32x16{};o[1]=f32x16{};
  const int qrel=wid*QBLK+r32;
  #define CMASK(P0,P1,t) do{int jb_=(t)-(NT-4); if(jb_>=0)cmask(P0,P1,jb_,qrel,hi);}while(0)
  bool resc=false;
  #define START(P0,P1) do{ const float rm=rowmax(P0,P1); resc=false; \
    { const float dl=rm; mhat=fadd_s(mhat,dl); \
      _Pragma("unroll") for(int r=0;r<16;++r){P0[r]=fsub_s(P0[r],dl);P1[r]=fsub_s(P1[r],dl);} \
      nq=fq_l2-mhat; } \
    _Pragma("unroll") for(int r=0;r<16;++r)P0[r]=__builtin_amdgcn_exp2f(P0[r]); }while(0)
  #define RESC() do{ if(resc){ asm volatile("s_waitcnt lgkmcnt(0)":::"memory"); \
      _Pragma("unroll") for(int d_=0;d_<2;++d_) _Pragma("unroll") for(int r=0;r<16;++r)o[d_][r]*=wsf[crow(r,hi)]; } }while(0)
  f32x16 pA0,pA1,pB0,pB1;
  int sl_prev=0,sl_cur=0,sl_next=SLOTB;
  #define ROT() do{sl_prev=sl_cur;sl_cur=sl_next;sl_next=(sl_next==(NSLOT-1)*SLOTB)?0:sl_next+SLOTB;}while(0)
  DMA_K(2,2*SLOTB);
  WAIT_BAR(3);
  fq_l2=*((__attribute__((address_space(3))) const float*)(shm3+LDS_F)+q0+qrel); nq=fq_l2;
  binit(pA0,pA1,fbase,nq);
  qkt(pA0,pA1,Kbase,qr,r32,hi);asm volatile("s_nop 15\n\ts_nop 7":"+v"(pA0),"+v"(pA1));CMASK(pA0,pA1,0);
  START(pA0,pA1);
  _Pragma("unroll") for(int r=0;r<16;++r)pA1[r]=__builtin_amdgcn_exp2f(pA1[r]);
  WAIT_BAR(0);
  DMA_K(3,0);DMA_V(1,SLOTB);
  ROT();
  kload8(kf,kp0+sl_cur);
  WAIT_BAR(2);
  s16x4 vlo[8],vhi[8]; u32x4 pw0,pw1,pw2,pw3;
  #define PKW(P,B) cvtpk_s(P[B],P[B+1])
  #define PAF(k) __builtin_bit_cast(bf16x8,pw##k)
  #define VFR(i) (bf16x8){vlo[i][0],vlo[i][1],vlo[i][2],vlo[i][3],vhi[i][0],vhi[i][1],vhi[i][2],vhi[i][3]}
  #define PIN(x) asm volatile("":"+v"(x))
  #define MX3(a,b,c) __builtin_fmaxf(__builtin_fmaxf((a),(b)),(c))
  #define GAPA(MF,A0,A1,A2,A3,W0,W1,PW) do{ MF; sacc+=A0; sacc+=A1; sacc+=A2; sacc+=A3; PIN(sacc); W0; W1; PIN(PW); SBAR(); }while(0)
  #define EX(v) __builtin_amdgcn_exp2f(v)
  #define GAPB(MF,X,B) do{ MF; X[B]=EX(X[B]); X[B+1]=EX(X[B+1]); X[B+2]=EX(X[B+2]); X[B+3]=EX(X[B+3]); PIN(X); SBAR(); }while(0)
  #define VRD(i) do{ vlo[i]=vtr(vp_+(((i)>>2)*4096+((i)&3)*1024)); vhi[i]=vtr(vp_+(((i)>>2)*4096+((i)&3)*1024+512)); }while(0)
  #define KRD(G,j) do{ if(G){ kload2(kf,kp0+sl_next,j); SBAR(); } }while(0)
  #define STEP(C0,C1,P0,P1,t,GK,GV,GL) do{ const lds_f4ptr fp_=(lds_f4ptr)((lds_cptr)fbase+256*(t)); binit1(C0,fp_,nq); SBAR(); \
    const lds_cptr vp_=vp0+sl_prev; \
    VRD(0); SBAR(); float sacc=(P0[0]+P0[1]); \
    GAPA(C0=__builtin_amdgcn_mfma_f32_32x32x16_bf16(kf[0],qr[0],C0,0,0,0), P0[2],P0[3],P0[4],P0[5],     pw0[0]=PKW(P0,0), pw0[1]=PKW(P0,2), pw0); \
    binit1(C1,fp_+8,nq); VRD(4); SBAR(); GAPA(C1=__builtin_amdgcn_mfma_f32_32x32x16_bf16(kf[1],qr[0],C1,0,0,0), P0[6],P0[7],P0[8],P0[9],     pw0[2]=PKW(P0,4), pw0[3]=PKW(P0,6), pw0); \
    VRD(1); SBAR(); GAPA(C0=__builtin_amdgcn_mfma_f32_32x32x16_bf16(kf[2],qr[1],C0,0,0,0),   P0[10],P0[11],P0[12],P0[13], pw1[0]=PKW(P0,8), pw1[1]=PKW(P0,10), pw1); \
    VRD(5); SBAR(); GAPA(C1=__builtin_amdgcn_mfma_f32_32x32x16_bf16(kf[3],qr[1],C1,0,0,0),   P0[14],P0[15],P1[0],P1[1],   pw1[2]=PKW(P0,12),pw1[3]=PKW(P0,14), pw1); \
    VRD(2); SBAR(); GAPA(C0=__builtin_amdgcn_mfma_f32_32x32x16_bf16(kf[4],qr[2],C0,0,0,0),   P1[2],P1[3],P1[4],P1[5],     pw2[0]=PKW(P1,0), pw2[1]=PKW(P1,2), pw2); \
    VRD(6); SBAR(); GAPA(C1=__builtin_amdgcn_mfma_f32_32x32x16_bf16(kf[5],qr[2],C1,0,0,0),   P1[6],P1[7],P1[8],P1[9],     pw2[2]=PKW(P1,4), pw2[3]=PKW(P1,6), pw2); \
    VRD(3); SBAR(); GAPA(C0=__builtin_amdgcn_mfma_f32_32x32x16_bf16(kf[6],qr[3],C0,0,0,0),   P1[10],P1[11],P1[12],P1[13], pw3[0]=PKW(P1,8), pw3[1]=PKW(P1,10), pw3); \
    VRD(7); SBAR(); GAPA(C1=__builtin_amdgcn_mfma_f32_32x32x16_bf16(kf[7],qr[3],C1,0,0,0),   P1[14],P1[15],0.f,0.f,       pw3[2]=PKW(P1,12),pw3[3]=PKW(P1,14), pw3); \
    l_reg+=sacc; \
    if(GK){DMA_K((t)+3,sl_cur);} if(GV){DMA_V((t)+1,sl_next);} \
    CMASK(C0,C1,t); \
    { float a=MX3(C0[0],C0[1],C1[0]),b=MX3(C0[2],C0[3],C1[1]); a=MX3(a,C1[2],C1[3]); \
      _Pragma("unroll") for(int r=4;r<16;r+=4){a=MX3(a,C0[r],C0[r+1]);b=MX3(b,C0[r+2],C0[r+3]);a=MX3(a,C1[r],C1[r+1]);b=MX3(b,C1[r+2],C1[r+3]);} \
      float rm=__builtin_fmaxf(a,b); { auto rr=__builtin_amdgcn_permlane32_swap(__float_as_uint(rm),__float_as_uint(rm),false,false); rm=__builtin_fmaxf(__uint_as_float(rr[0]),__uint_as_float(rr[1])); } \
      resc=false; \
      if(__builtin_expect(__any(rm>(float)THRL),0)){ const float dl=__builtin_fmaxf(rm,0.f); mhat+=dl; \
        _Pragma("unroll") for(int r=0;r<16;++r){C0[r]-=dl;C1[r]-=dl;} \
        nq=fq_l2-mhat; \
        const float f=__builtin_amdgcn_exp2f(-dl); l_reg*=f; if(hi==0)wsf[r32]=f; resc=true; } } \
    SBAR(); \
    GAPB(o[0]=__builtin_amdgcn_mfma_f32_32x32x16_bf16(PAF(0),VFR(0),o[0],0,0,0), C0,0); \
    GAPB(o[1]=__builtin_amdgcn_mfma_f32_32x32x16_bf16(PAF(0),VFR(4),o[1],0,0,0), C0,4); \
    KRD(GL,0); GAPB(o[0]=__builtin_amdgcn_mfma_f32_32x32x16_bf16(PAF(1),VFR(1),o[0],0,0,0), C0,8); \
    KRD(GL,1); GAPB(o[1]=__builtin_amdgcn_mfma_f32_32x32x16_bf16(PAF(1),VFR(5),o[1],0,0,0), C0,12); \
    KRD(GL,2); GAPB(o[0]=__builtin_amdgcn_mfma_f32_32x32x16_bf16(PAF(2),VFR(2),o[0],0,0,0), C1,0); \
    KRD(GL,3); GAPB(o[1]=__builtin_amdgcn_mfma_f32_32x32x16_bf16(PAF(2),VFR(6),o[1],0,0,0), C1,4); \
    GAPB(o[0]=__builtin_amdgcn_mfma_f32_32x32x16_bf16(PAF(3),VFR(3),o[0],0,0,0), C1,8); \
    GAPB(o[1]=__builtin_amdgcn_mfma_f32_32x32x16_bf16(PAF(3),VFR(7),o[1],0,0,0), C1,12); \
    }while(0)
  int t=1;
  #undef CMASK
  #define CMASK(P0,P1,t) do{}while(0)
  for(;t+5<NT;t+=2){
    STEP(pB0,pB1,pA0,pA1,t,true,true,true);     WAIT_BAR(2); RESC(); ROT();
    STEP(pA0,pA1,pB0,pB1,t+1,true,true,true);   WAIT_BAR(2); RESC(); ROT();
  }
  #undef CMASK
  #define CMASK(P0,P1,t) do{int jb_=(t)-(NT-4); if(jb_>=0)cmask(P0,P1,jb_,qrel,hi);}while(0)
  #define ENDW(tt) do{ if((tt)+3<NT){WAIT_BAR(2);} else if((tt)+2<NT){WAIT_BAR(1);} else {WAIT_BAR(0);} }while(0)
  for(;t+1<NT;t+=2){
    STEP(pB0,pB1,pA0,pA1,t,(t+3<NT),(t+1<NT),(t+1<NT));       ENDW(t);   RESC(); ROT();
    STEP(pA0,pA1,pB0,pB1,t+1,(t+4<NT),(t+2<NT),(t+2<NT));     ENDW(t+1); RESC(); ROT();
  }
  STEP(pB0,pB1,pA0,pA1,NT-1,false,false,false); RESC();
  { float sacc=pB0[0]+pB0[1]; _Pragma("unroll") for(int r=2;r<16;++r)sacc+=pB0[r]; _Pragma("unroll") for(int r=0;r<16;++r)sacc+=pB1[r]; l_reg+=sacc;
    pw0=(u32x4){PKW(pB0,0),PKW(pB0,2),PKW(pB0,4),PKW(pB0,6)};pw1=(u32x4){PKW(pB0,8),PKW(pB0,10),PKW(pB0,12),PKW(pB0,14)};pw2=(u32x4){PKW(pB1,0),PKW(pB1,2),PKW(pB1,4),PKW(pB1,6)};pw3=(u32x4){PKW(pB1,8),PKW(pB1,10),PKW(pB1,12),PKW(pB1,14)};
    SBAR(); pv(o,vb0+sl_cur,PAF(0),PAF(1),PAF(2),PAF(3)); }
  #undef PKW
  #undef PAF
  #undef VFR
  #undef PIN
  #undef MX3
  #undef GAPA
  #undef GAPB
  #undef EX
  #undef VRD
  #undef KRD
  #undef STEP
  #undef ENDW
  {auto rr=__builtin_amdgcn_permlane32_swap(__float_as_uint(l_reg),__float_as_uint(l_reg),false,false);l_reg=__uint_as_float(rr[0])+__uint_as_float(rr[1]);}
  if(hi==0)wsf[32+r32]=l_reg;asm volatile("s_waitcnt lgkmcnt(0)":::"memory");
  float rli[16];
  #pragma unroll
  for(int r=0;r<16;++r)rli[r]=__builtin_amdgcn_rcpf(wsf[32+crow(r,hi)]);
  bf16*Ow=O+(rowbase+q0+wid*QBLK)*DM+h*D;
  { bf16*stg=(bf16*)(shm+LDS_OST)+wid*2048;
    #pragma unroll
    for(int r=0;r<16;++r){const int orow=crow(r,hi);
      #pragma unroll
      for(int d0=0;d0<2;++d0)stg[orow*64+d0*32+r32]=__float2bfloat16(o[d0][r]*rli[r]);}
    asm volatile("s_waitcnt lgkmcnt(0)":::"memory");
    #pragma unroll
    for(int i=0;i<4;++i){const int row=i*8+(lane>>3),ch=lane&7; const u32x4 v=*(const u32x4*)(stg+row*64+ch*8); ATTN_STORE16(Ow+(long)row*DM+ch*8,v);} }
  asm volatile("s_waitcnt lgkmcnt(0)\n\ts_barrier":::"memory");
  #undef DMA_K
  #undef DMA_V
  #undef CMASK
  #undef START
  #undef RESC
  #undef ROT
}
constexpr int ATTN_LDS_BYTES=LDS_BYTES;
struct AttnTensors { const bf16* Q; const bf16* K; const bf16* V; bf16* O; const float* Fl2; };
struct AttnUnit { int bh; int qb; };
struct StaticOrder {
  int vcu;
  __device__ __forceinline__ explicit StaticOrder(int grid,int block):vcu((block%8)*(grid/8)+block/8){}
  __device__ __forceinline__ bool next(int i,AttnUnit&u)const{ if(i>=4||vcu>=256)return false; const int a=2*(vcu&1)+(i>>1); u.bh=vcu>>1; u.qb=(i&1)?7-a:a; return true; }
  __device__ __forceinline__ void a_ready(const AttnUnit&)const{}
  __device__ __forceinline__ void done(const AttnUnit&)const{}
};
template<class Sched,int THRL=40> __device__ __forceinline__ void attn_phase(char*lds,const AttnTensors&T,const Sched&S){
  AttnUnit u;
  for(int i=0;S.next(i,u);++i){ S.a_ready(u); attn_unit<THRL>(u.bh/NHEAD,u.bh%NHEAD,u.qb,T.Q,T.K,T.V,T.O,T.Fl2,lds); S.done(u); }
}
#undef SBAR
#undef WAIT_BAR
}

constexpr int RING_OFF = 0, RING_BYTES = 131072;
constexpr int LDSCTL_OFF = RING_BYTES, MISC_OFF = LDSCTL_OFF + 320;
constexpr int LDS_BYTES = 147456;
constexpr int NWAVES = 8;
static_assert(attn_body::ATTN_LDS_BYTES <= RING_BYTES, "attention scratch");

#define XB_TMO      128
#define XB_XCNT(j)  (256  + 64 * (j))
#define XB_XSUB(j)  (1280 + 64 * (j))
#define XB_XGEN(j)  (2304 + 64 * (j))
#define XB_TOP      3328
#define XB_TOPGEN   3392
#define XCD_BAR_WORDS 3456
#define XB_SPIN_CAP (1u << 18)
__device__ __forceinline__ unsigned xb_ld(unsigned* p)              { return __hip_atomic_load(p, __ATOMIC_RELAXED, __HIP_MEMORY_SCOPE_AGENT); }
__device__ __forceinline__ unsigned xb_add(unsigned* p, unsigned v) { return __hip_atomic_fetch_add(p, v, __ATOMIC_RELAXED, __HIP_MEMORY_SCOPE_AGENT); }
__device__ __forceinline__ unsigned xb_xcc_id() { return (unsigned)__builtin_amdgcn_s_getreg((3 << 11) | 20) & 0xFu; }
#define XB_SPIN(cond, bar) do { unsigned _sp = 0; while (cond) { __builtin_amdgcn_s_sleep(1); \
    if ((++_sp & 255u) == 0u) { if (xb_ld(&(bar)[XB_TMO])) break; if (_sp > XB_SPIN_CAP) { atomicAdd(&(bar)[XB_TMO], 1u); break; } } } } while (0)
struct XcdBarrier { unsigned* bar; unsigned x; volatile LAS unsigned* st; };
__device__ __forceinline__ XcdBarrier xcd_barrier_post(unsigned* bar, volatile LAS unsigned* st) {
    XcdBarrier b; b.bar = bar; b.x = xb_xcc_id(); b.st = st;
    if (threadIdx.x == 0) (void)xb_add(&bar[XB_XCNT(b.x)], 1u);
    return b;
}
__device__ __forceinline__ void xcd_barrier_complete(unsigned* bar, unsigned x, unsigned& nloc, unsigned& nx) {
    const unsigned G = gridDim.x * gridDim.y * gridDim.z;
    unsigned sum, cnt, mine, sp = 0u;
    for (;;) {
        sum = 0u; cnt = 0u; mine = 0u;
#pragma unroll
        for (unsigned j = 0; j < 16; ++j) { const unsigned c = xb_ld(&bar[XB_XCNT(j)]); sum += c; cnt += (c > 0u) ? 1u : 0u; mine = (j == x) ? c : mine; }
        if (sum == G) break;
        __builtin_amdgcn_s_sleep(1);
        if ((++sp & 255u) == 0u) { if (xb_ld(&bar[XB_TMO])) break; if (sp > XB_SPIN_CAP) { atomicAdd(&bar[XB_TMO], 1u); break; } }
    }
    nloc = mine > 0u ? mine : 1u; nx = cnt > 0u ? cnt : 1u;
}
__device__ __forceinline__ void xcd_barrier(const XcdBarrier& b) {
    asm volatile("s_waitcnt vmcnt(0)" ::: "memory");
    __syncthreads();
    if (threadIdx.x == 0) {
        unsigned* bar = b.bar;
        __builtin_amdgcn_s_waitcnt(0);
        unsigned nloc = b.st[0], nx = b.st[1];
        if (nloc == 0u) { xcd_barrier_complete(bar, b.x, nloc, nx); b.st[0] = nloc; b.st[1] = nx; }
        const unsigned old = xb_add(&bar[XB_XSUB(b.x)], 1u);
        const unsigned gen = old / nloc;
        if (old + 1u == (gen + 1u) * nloc) {
            __builtin_amdgcn_fence(__ATOMIC_RELEASE, "agent");
            asm volatile("s_waitcnt vmcnt(0)" ::: "memory");
            const unsigned og = xb_add(&bar[XB_TOP], 1u);
            const unsigned tg = og / nx;
            if (og + 1u == (tg + 1u) * nx) xb_add(&bar[XB_TOPGEN], 1u);
            else XB_SPIN(xb_ld(&bar[XB_TOPGEN]) == tg, bar);
            __builtin_amdgcn_fence(__ATOMIC_ACQUIRE, "agent");
            xb_add(&bar[XB_XGEN(b.x)], 1u);
            asm volatile("s_waitcnt vmcnt(0)" ::: "memory");
        } else {
            XB_SPIN(xb_ld(&bar[XB_XGEN(b.x)]) == gen, bar);
            __builtin_amdgcn_fence(__ATOMIC_ACQUIRE, "agent");
            asm volatile("s_waitcnt vmcnt(0)" ::: "memory");
        }
    }
    __syncthreads();
}

__device__ __forceinline__ void* ld_ptr(LAS unsigned long long* PT, int i) { const volatile LAS unsigned* p = (const volatile LAS unsigned*)(PT + i); const unsigned lo = __builtin_amdgcn_readfirstlane(p[0]), hi = __builtin_amdgcn_readfirstlane(p[1]); return (void*)(GAS void*)(((unsigned long long)hi << 32) | lo); }
struct TrItem { const float* W; bf16_t* WT; int pitch, srccol0, Kd, dstrow0, k0, f8; unsigned char* WT8; };
__device__ __forceinline__ void tr_load(f32x4 (&v)[16], const TrItem& t, int lane) {
    const int lr = lane >> 4, lc = 4 * (lane & 15);
#pragma unroll
    for (int j = 0; j < 16; ++j) v[j] = *(const GAS f32x4*)(t.W + (size_t)(t.k0 + 16 * lr + j) * t.pitch + t.srccol0 + lc);
}
__device__ __forceinline__ void tr_store(const f32x4 (&v)[16], const TrItem& t, int lane) {
    const int lr = lane >> 4, lc = 4 * (lane & 15);
    const size_t eoff = (size_t)(t.dstrow0 + lc) * t.Kd + t.k0 + 16 * lr;
    if (t.f8 == 1 || t.f8 == 2) {
        GAS unsigned char* dst8 = (GAS unsigned char*)(t.f8 == 2 ? t.WT8 : (unsigned char*)t.WT) + eoff;
#pragma unroll
        for (int q = 0; q < 4; ++q) { u32x4 o;
#pragma unroll
            for (int w = 0; w < 4; ++w) { int pw = 0; pw = __builtin_amdgcn_cvt_pk_fp8_f32(64.f * v[4 * w][q], 64.f * v[4 * w + 1][q], pw, false); pw = __builtin_amdgcn_cvt_pk_fp8_f32(64.f * v[4 * w + 2][q], 64.f * v[4 * w + 3][q], pw, true); o[w] = (unsigned)pw; }
            *(GAS u32x4*)(dst8 + (size_t)q * t.Kd) = o; }
    }
    if (t.f8 == 3) {
        const f32x4 cm = *(const GAS f32x4*)((const GAS float*)t.WT8 + t.dstrow0 + lc);
        GAS unsigned char* dst8 = (GAS unsigned char*)t.WT + eoff;
#pragma unroll
        for (int q = 0; q < 4; ++q) { const float qs = 127.0f / fmaxf(cm[q], 1e-30f); u32x4 o;
#pragma unroll
            for (int w = 0; w < 4; ++w) o[w] = pack_i8(qs * v[4 * w][q], qs * v[4 * w + 1][q], qs * v[4 * w + 2][q], qs * v[4 * w + 3][q]);
            *(GAS u32x4*)(dst8 + (size_t)q * t.Kd) = o; }
    }
    if (t.f8 == 0 || t.f8 == 2) {
        GAS bf16_t* dst = (GAS bf16_t*)t.WT + eoff;
#pragma unroll
        for (int q = 0; q < 4; ++q) { u32x4 o0, o1;
#pragma unroll
            for (int w = 0; w < 4; ++w) { o0[w] = pk2(v[2 * w][q], v[2 * w + 1][q]); o1[w] = pk2(v[8 + 2 * w][q], v[8 + 2 * w + 1][q]); }
            *(GAS u32x4*)(dst + (size_t)q * t.Kd) = o0; *(GAS u32x4*)(dst + (size_t)q * t.Kd + 8) = o1; }
    }
}
__device__ __forceinline__ int up_row(int n0, int which) { return (n0 >> 7) * 256 + (n0 & 127) + which * 128; }

constexpr size_t WIN_LSTRIDE = (size_t)3 * 1024 * 1024;
struct P0Ptrs { const float *w_in, *w_glu, *w_pa, *w_ps, *w_out, *w1d, *w3d, *w2d; bf16_t *WIN, *WGLU, *WPA, *WPS, *WOUT, *WUPD, *WDND; float* CMAX; };
constexpr int TI_IN = 16 * 64, TI_GLU = 8 * 8, TI_P = 8 * 16, TI_O = 16 * 16, TI_L = TI_IN + TI_GLU + 2 * TI_P + TI_O, TI_UP = 16 * 44, TI_DN = 44 * 16, TI_P0 = 2 * TI_L + 2 * TI_UP + TI_DN, TI_E = 2 * TI_UP + TI_DN;
__device__ __forceinline__ void make_p0_item(TrItem& t, int it, const P0Ptrs& P) {
    int r = it;
    if (r < 2 * TI_L) { const int l = r / TI_L; r -= l * TI_L;
        if (r < TI_IN) { const int kb = r / 64, nb = r % 64, n0 = 64 * nb;
            t = TrItem{P.w_in + (size_t)l * 1024 * NIN_SRC, P.WIN + (size_t)l * WIN_LSTRIDE, NIN_SRC, n0 < 1536 ? n0 : n0 + 8, 1024, n0, 64 * kb, 3, (unsigned char*)(P.CMAX + l * 4096)}; return; } r -= TI_IN;
        if (r < TI_GLU) { const int kb = r / 8, nb = r % 8; t = TrItem{P.w_glu + (size_t)l * 512 * 512, P.WGLU + (size_t)l * 512 * 512, 512, 64 * nb, 512, 64 * nb, 64 * kb, 0, nullptr}; return; } r -= TI_GLU;
        if (r < TI_P) { const int kb = r / 16, nb = r % 16; t = TrItem{P.w_pa + (size_t)l * 512 * 1024, P.WPA + (size_t)l * 1024 * 512, 1024, 64 * nb, 512, 64 * nb, 64 * kb, 0, nullptr}; return; } r -= TI_P;
        if (r < TI_P) { const int kb = r / 16, nb = r % 16; t = TrItem{P.w_ps + (size_t)l * 512 * 1024, P.WPS + (size_t)l * 1024 * 512, 1024, 64 * nb, 512, 64 * nb, 64 * kb, 0, nullptr}; return; } r -= TI_P;
        { const int kb = r / 16, nb = r % 16; t = TrItem{P.w_out + (size_t)l * 1024 * 1024, P.WOUT + (size_t)l * 1024 * 1024, 1024, 64 * nb, 1024, 64 * nb, 64 * kb, 0, nullptr}; return; }
    }
    r -= 2 * TI_L;
    if (r < TI_UP) { const int kb = r / 44, nb = r % 44; t = TrItem{P.w1d, P.WUPD, DFF, 64 * nb, 1024, up_row(64 * nb, 0), 64 * kb, 3, (unsigned char*)(P.CMAX + 8192)}; return; } r -= TI_UP;
    if (r < TI_UP) { const int kb = r / 44, nb = r % 44; t = TrItem{P.w3d, P.WUPD, DFF, 64 * nb, 1024, up_row(64 * nb, 1), 64 * kb, 3, (unsigned char*)(P.CMAX + 8192)}; return; } r -= TI_UP;
    { const int kb = r / 16, nb = r % 16; t = TrItem{P.w2d, P.WDND, 1024, 64 * nb, DFF, 64 * nb, 64 * kb, DENSE_DOWN_FP8, nullptr}; }
}
struct MoePtrs { const float *w1m, *w3m, *w2m; bf16_t *WUPM, *WDNM; unsigned char* WUP8; };
constexpr int MOE_ROUNDS_UP = 8 * 2 * 11 * 8, MOE_ROUNDS = MOE_ROUNDS_UP + 8 * 8 * 11;
constexpr int MOE_R_S5 = 3, MOE_R_SORT0 = 2 * 112 * MOE_R_S5, MOE_R_NORM0 = MOE_R_SORT0 + 255, MOE_R_NORM_EACH = 4, MOE_R_TAIL0 = MOE_R_NORM0 + 256 * MOE_R_NORM_EACH;
static_assert(MOE_R_TAIL0 <= MOE_ROUNDS && MOE_ROUNDS - MOE_R_TAIL0 <= 256, "MoE conversion shares");
__device__ __forceinline__ void make_moe_item(TrItem& t, int it, const MoePtrs& P) {
    const int rho = it >> 3, w = it & 7;
    if (rho < MOE_ROUNDS_UP) { const int tile = rho >> 3, i = rho & 7, e = tile / 22, rem = tile % 22, which = rem / 11, nb = 4 * (rem % 11) + (w & 3), kb = 2 * i + (w >> 2);
        t = TrItem{(which ? P.w3m : P.w1m) + (size_t)e * 1024 * DFF, (bf16_t*)(P.WUP8 + (size_t)e * 5632 * 1024), DFF, 64 * nb, 1024, up_row(64 * nb, which), 64 * kb, 1, nullptr}; return; }
    { const int r2 = rho - MOE_ROUNDS_UP, tile = r2 / 11, i = r2 % 11, e = tile >> 3, rem = tile & 7, nb = 4 * (rem >> 1) + (w & 3), kb = 22 * (rem & 1) + 2 * i + (w >> 2);
        t = TrItem{P.w2m + (size_t)e * DFF * 1024, P.WDNM + (size_t)e * 512 * DFF, 1024, 64 * nb, DFF, 64 * nb, 64 * kb, 1, nullptr}; }
}
__device__ __forceinline__ void colmax_item(LAS unsigned char* lds, int tid, const float* W, int pitch, int srccol0, float* out) {
    const int q = tid & 15, r = tid >> 4; f32x4 m = (f32x4){0.f, 0.f, 0.f, 0.f};
    for (int i0 = 0; i0 < 32; i0 += 8) { f32x4 v[8];
#pragma unroll
        for (int j = 0; j < 8; ++j) v[j] = *(const GAS f32x4*)(W + (size_t)(r + 32 * (i0 + j)) * pitch + srccol0 + 4 * q);
#pragma unroll
        for (int j = 0; j < 8; ++j) { m[0] = fmaxf(m[0], fabsf(v[j][0])); m[1] = fmaxf(m[1], fabsf(v[j][1])); m[2] = fmaxf(m[2], fabsf(v[j][2])); m[3] = fmaxf(m[3], fabsf(v[j][3])); } }
    LAS float* red = (LAS float*)lds;
    *(LAS f32x4*)(red + r * 64 + 4 * q) = m;
    LDS_WAIT(); __syncthreads();
    if (tid < 64) { float mm = 0.f;
#pragma unroll
        for (int rr = 0; rr < 32; ++rr) mm = fmaxf(mm, red[rr * 64 + tid]);
        out[tid] = mm; }
    LDS_WAIT(); __syncthreads();
}
constexpr int CM_ITEMS = 128 + 88;
#define TR_LOOP(FIRST, N, STRIDE, MAKE, PTRS) do { int it_ = (FIRST); TrItem ta_, tb_; f32x4 va_[16], vb_[16]; \
    if (it_ < (N)) { MAKE(ta_, it_, PTRS); tr_load(va_, ta_, lane); } \
    while (it_ < (N)) { const int i2_ = it_ + (STRIDE); if (i2_ < (N)) { MAKE(tb_, i2_, PTRS); tr_load(vb_, tb_, lane); } tr_store(va_, ta_, lane); \
        if (i2_ >= (N)) break; const int i3_ = i2_ + (STRIDE); if (i3_ < (N)) { MAKE(ta_, i3_, PTRS); tr_load(va_, ta_, lane); } tr_store(vb_, tb_, lane); it_ = i3_; } } while (0)

__device__ __forceinline__ void s5_gen(LAS unsigned char* lds, int tid, const float* lam_re, const float* lam_im, const float* log_dt, const float* b_re, const float* b_im,
                                       const float* c_re, const float* c_im, bf16_t* TG, bf16_t* WST, float* A32) {
    constexpr int GS = 65, KT = 20, KH = 32 * KT;
    LAS float* Gre = (LAS float*)lds;
    LAS float* Gim = Gre + 33 * GS + 3;
    LAS float* Bbr = Gim + 33 * GS + 3;
    LAS float* Bbi = Bbr + 1024;
    LAS float* CrT = Bbi + 1024;
    LAS float* CiT = CrT + 1024;
    LAS float* kk = CiT + 1024;
    LAS float* Kt = kk + 128 + 28;
    const double dt = exp((double)log_dt[0]);
    { const int p = tid & 63, sl = tid >> 6;
        const double lr = (double)lam_re[p], li = (double)lam_im[p];
        for (int tau = sl; tau <= 32; tau += 8) { const double mg = exp(lr * dt * (double)tau), ang = li * dt * (double)tau; double sn, cs; sincos(ang, &sn, &cs);
            Gre[tau * GS + p] = (float)(mg * cs); Gim[tau * GS + p] = (float)(mg * sn);
            if (tau == 32) { A32[2 * p] = (float)(mg * cs); A32[2 * p + 1] = (float)(mg * sn); } }
        if (sl == 0) { const double mg = exp(lr * dt), ang = li * dt; double sn, cs; sincos(ang, &sn, &cs); const double nr = mg * cs - 1.0, ni = mg * sn, den = lr * lr + li * li;
            kk[2 * p] = (float)((nr * lr + ni * li) / den); kk[2 * p + 1] = (float)((ni * lr - nr * li) / den); } }
    for (int i = tid; i < 1024; i += 512) { const int ho = i >> 6, p = i & 63; CrT[p * 16 + ho] = c_re[i]; CiT[p * 16 + ho] = c_im[i]; }
    LDS_WAIT(); __syncthreads();
    for (int i = tid; i < 1024; i += 512) { const int p = i >> 4; const float kr = kk[2 * p], ki = kk[2 * p + 1], br = b_re[i], bi = b_im[i]; Bbr[i] = kr * br - ki * bi; Bbi[i] = kr * bi + ki * br; }
    LDS_WAIT(); __syncthreads();
    {
        const int tau = tid >> 4, ho = tid & 15; f32x2 a2[8];
#pragma unroll
        for (int i = 0; i < 8; ++i) a2[i] = (f32x2){0.f, 0.f};
        for (int p0 = 0; p0 < 64; p0 += 4) { float er[4], ei[4];
#pragma unroll
            for (int pp = 0; pp < 4; ++pp) { const int p = p0 + pp; const float cr = CrT[p * 16 + ho], ci = CiT[p * 16 + ho], gr = Gre[tau * GS + p], gi = Gim[tau * GS + p];
                er[pp] = cr * gr - ci * gi; ei[pp] = -(cr * gi + ci * gr); }
#pragma unroll
            for (int pp = 0; pp < 4; ++pp) { const LAS f32x4* br4 = (const LAS f32x4*)(Bbr + (p0 + pp) * 16); const LAS f32x4* bi4 = (const LAS f32x4*)(Bbi + (p0 + pp) * 16);
                const f32x2 e2 = (f32x2){er[pp], er[pp]}, f2 = (f32x2){ei[pp], ei[pp]};
#pragma unroll
                for (int q = 0; q < 4; ++q) { const f32x4 br = br4[q], bi = bi4[q];
                    a2[2 * q] += e2 * (f32x2){br[0], br[1]} + f2 * (f32x2){bi[0], bi[1]}; a2[2 * q + 1] += e2 * (f32x2){br[2], br[3]} + f2 * (f32x2){bi[2], bi[3]}; } } }
        LAS f32x4* kd = (LAS f32x4*)(Kt + ho * KH + tau * KT);
#pragma unroll
        for (int q = 0; q < 4; ++q) kd[q] = (f32x4){a2[2 * q][0], a2[2 * q][1], a2[2 * q + 1][0], a2[2 * q + 1][1]}; }
    {
        for (int pc = tid; pc < 128 * 64; pc += 512) { const int n = pc >> 6, c = pc & 63, p = n >> 1, ri = n & 1, j = c >> 1, h8 = 8 * (c & 1);
            const float gr = Gre[(31 - j) * GS + p], gi = Gim[(31 - j) * GS + p]; float v[8];
#pragma unroll
            for (int hi = 0; hi < 8; ++hi) { const float br = Bbr[p * 16 + h8 + hi], bi = Bbi[p * 16 + h8 + hi]; v[hi] = ri ? (gr * bi + gi * br) : (gr * br - gi * bi); }
            u32x4 o; o.x = pk2(v[0], v[1]); o.y = pk2(v[2], v[3]); o.z = pk2(v[4], v[5]); o.w = pk2(v[6], v[7]);
            *(GAS u32x4*)(WST + (size_t)pc * 8) = o; }
        const u32x4 z = (u32x4){0u, 0u, 0u, 0u};
        for (int i = tid; i < 128 * 512 / 8; i += 512) *(GAS u32x4*)(WST + (size_t)128 * 512 + (size_t)i * 8) = z; }
    LDS_WAIT(); __syncthreads();
    {
#pragma unroll 2
        for (int row = tid >> 6; row < 512; row += 8) { const int cp = tid & 63, t = row >> 4, ho = row & 15, s = cp >> 1; u32x4 o = (u32x4){0u, 0u, 0u, 0u};
            if (s <= t) { const LAS f32x4* kp = (const LAS f32x4*)(Kt + ho * KH + (t - s) * KT + 8 * (cp & 1)); const f32x4 k0 = kp[0], k1 = kp[1];
                o.x = pk2(k0[0], k0[1]); o.y = pk2(k0[2], k0[3]); o.z = pk2(k1[0], k1[1]); o.w = pk2(k1[2], k1[3]); }
            *(GAS u32x4*)(TG + (size_t)row * 640 + cp * 8) = o; }
#pragma unroll 2
        for (int pc = tid; pc < 512 * 16; pc += 512) { const int row = pc >> 4, p4 = 4 * (pc & 15), t = row >> 4, ho = row & 15; u32x4 o;
#pragma unroll
            for (int pp = 0; pp < 4; ++pp) { const int p = p4 + pp; const float cr = CrT[p * 16 + ho], ci = CiT[p * 16 + ho], g1r = Gre[(t + 1) * GS + p], g1i = Gim[(t + 1) * GS + p];
                o[pp] = pk2(cr * g1r - ci * g1i, -(cr * g1i + ci * g1r)); }
            *(GAS u32x4*)(TG + (size_t)row * 640 + 512 + 2 * p4) = o; } }
    LDS_WAIT(); __syncthreads();
}

__device__ __forceinline__ void ada_item(LAS unsigned char* lds, int tid, const float* c, const float* W, const float* bias, float* ada_l, int cg) {
    LAS float* sc = (LAS float*)lds;
    LAS float* red = sc + 16384;
    for (int i = tid; i < 16384; i += 512) { const int b = i >> 10, k = i & 1023; const float v = c[i]; sc[k * 16 + b] = v * fast_sigmoid(v); }
    LDS_WAIT(); __syncthreads();
    const int col = tid & 63, ks = tid >> 6; float a[16];
#pragma unroll
    for (int b = 0; b < 16; ++b) a[b] = 0.f;
    for (int k0 = ks * 128; k0 < ks * 128 + 128; k0 += 16) { float wv[16];
#pragma unroll
        for (int uu = 0; uu < 16; ++uu) wv[uu] = W[(size_t)(k0 + uu) * 6144 + cg * 64 + col];
#pragma unroll
        for (int uu = 0; uu < 16; ++uu) { const float w = wv[uu]; const LAS f32x4* s4 = (const LAS f32x4*)(sc + (k0 + uu) * 16);
#pragma unroll
            for (int q = 0; q < 4; ++q) { const f32x4 s = s4[q]; a[4 * q] += s[0] * w; a[4 * q + 1] += s[1] * w; a[4 * q + 2] += s[2] * w; a[4 * q + 3] += s[3] * w; } } }
#pragma unroll
    for (int b = 0; b < 16; ++b) red[(ks * 16 + b) * 64 + col] = a[b];
    LDS_WAIT(); __syncthreads();
    for (int o = tid; o < 1024; o += 512) { const int b = o >> 6, cc = o & 63; float s = 0.f;
#pragma unroll
        for (int q = 0; q < 8; ++q) s += red[(q * 16 + b) * 64 + cc];
        ada_l[(size_t)b * 6144 + cg * 64 + cc] = s + bias[cg * 64 + cc]; }
    LDS_WAIT(); __syncthreads();
}

__device__ __forceinline__ float reduce8(const float (&d)[8], int lane) {
    const bool b0 = lane & 1, b1 = lane & 2, b2 = lane & 4; float t[4], u[2];
#pragma unroll
    for (int i = 0; i < 4; ++i) { const float send = b0 ? d[i] : d[i + 4], keep = b0 ? d[i + 4] : d[i]; t[i] = keep + dpp_f<0xB1, 0xF, 0xF>(0.f, send); }
#pragma unroll
    for (int i = 0; i < 2; ++i) { const float send = b1 ? t[i] : t[i + 2], keep = b1 ? t[i + 2] : t[i]; u[i] = keep + dpp_f<0x4E, 0xF, 0xF>(0.f, send); }
    float v; { const float send = b2 ? u[0] : u[1], keep = b2 ? u[1] : u[0]; float x = dpp_f<0x104, 0xF, 0x5>(0.f, send); x = dpp_f<0x114, 0xF, 0xA>(x, send); v = keep + x; }
    v += dpp_f<0x128, 0xF, 0xF>(0.f, v);
    v = xor16_sum(v); v = xor32_sum(v);
    return v;
}
template <bool XBF> struct NormRaw { typedef f32x4 T; };
template <> struct NormRaw<true> { typedef u32x2 T; };
template <int NR, bool XBF>
__device__ __forceinline__ void norm_load(typename NormRaw<XBF>::T (&raw)[NR][4], const float* xin, const bf16_t* xbin, int row, int lane) {
#pragma unroll
    for (int r = 0; r < NR; ++r) {
        if constexpr (XBF) { const GAS u32x2* xr = (const GAS u32x2*)(xbin + (size_t)(row + r) * 1024) + lane;
#pragma unroll
            for (int j = 0; j < 4; ++j) raw[r][j] = xr[64 * j]; }
        else { const GAS f32x4* xr = (const GAS f32x4*)(xin + (size_t)(row + r) * 1024) + lane;
#pragma unroll
            for (int j = 0; j < 4; ++j) raw[r][j] = xr[64 * j]; } }
}
template <int MODE, int NR, int OUTK, bool XBF>
__device__ __forceinline__ void norm_proc(const typename NormRaw<XBF>::T (&raw)[NR][4], const f32x4 (&gm)[4], const f32x4 (&sh)[4], bf16_t* H, unsigned char* H8, float* SA, int row0, int i0, int wave, int lane, LAS float* W8, LAS int* tokE,
                                          int eidx, float bias_e, float* logf, int* toke, float* tokw) {
    f32x4 v[NR][4];
#pragma unroll
    for (int r = 0; r < NR; ++r)
#pragma unroll
        for (int j = 0; j < 4; ++j) { if constexpr (XBF) { const u32x2 w = raw[r][j]; v[r][j] = (f32x4){bf_lo(w.x), bf_hi(w.x), bf_lo(w.y), bf_hi(w.y)}; } else v[r][j] = raw[r][j]; }
#pragma unroll
    for (int r = 0; r < NR; ++r) {
        const int row = row0 + i0 + r; float ss = 0.f;
#pragma unroll
        for (int j = 0; j < 4; ++j) ss += (v[r][j].x * v[r][j].x + v[r][j].y * v[r][j].y) + (v[r][j].z * v[r][j].z + v[r][j].w * v[r][j].w);
        const float rstd = __builtin_amdgcn_rsqf(wave_sum(ss) * (1.0f / 1024.0f) + EPS_RMS);
#pragma unroll
        for (int j = 0; j < 4; ++j) v[r][j] = v[r][j] * rstd * gm[j] + sh[j];
        if (OUTK == 2) { float mx = 0.f;
#pragma unroll
            for (int j = 0; j < 4; ++j) mx = fmaxf(fmaxf(mx, fmaxf(fabsf(v[r][j].x), fabsf(v[r][j].y))), fmaxf(fabsf(v[r][j].z), fabsf(v[r][j].w)));
            mx = wave_max_nonneg(mx);
            const float qs = 127.0f * __builtin_amdgcn_rcpf(fmaxf(mx, 1e-30f));
            GAS unsigned* o4 = (GAS unsigned*)((GAS unsigned char*)H8 + (size_t)row * 1024) + lane;
#pragma unroll
            for (int j = 0; j < 4; ++j) o4[64 * j] = pack_i8(v[r][j].x * qs, v[r][j].y * qs, v[r][j].z * qs, v[r][j].w * qs);
            if (lane == 0) SA[row] = mx * (1.0f / 127.0f); }
        if (OUTK == 1 || OUTK == 3) { GAS unsigned* o4 = (GAS unsigned*)((GAS unsigned char*)H8 + (size_t)row * 1024) + lane;
#pragma unroll
            for (int j = 0; j < 4; ++j) { int pw = 0; pw = __builtin_amdgcn_cvt_pk_fp8_f32(v[r][j].x, v[r][j].y, pw, false); pw = __builtin_amdgcn_cvt_pk_fp8_f32(v[r][j].z, v[r][j].w, pw, true); o4[64 * j] = (unsigned)pw; } }
        if (OUTK < 2) { GAS unsigned long long* o8 = (GAS unsigned long long*)(H + (size_t)row * 1024) + lane;
#pragma unroll
            for (int j = 0; j < 4; ++j) o8[64 * j] = (unsigned long long)cvt_pk_bf16(v[r][j].x, v[r][j].y) | ((unsigned long long)cvt_pk_bf16(v[r][j].z, v[r][j].w) << 32); }
    }
    if (MODE != 0) {
        f32x2 d2[NR][4];
#pragma unroll
        for (int r = 0; r < NR; ++r)
#pragma unroll
            for (int e = 0; e < 4; ++e) d2[r][e] = (f32x2){0.f, 0.f};
        int w8o = 0; asm volatile("" : "+v"(w8o));
#pragma unroll
        for (int j = 0; j < 4; ++j)
#pragma unroll
            for (int q = 0; q < 4; ++q) { const LAS f32x4* wp = (const LAS f32x4*)(W8 + w8o + (4 * lane + 256 * j + q) * 8); const f32x4 w0 = wp[0], w1 = wp[1];
#pragma unroll
                for (int r = 0; r < NR; ++r) { const float hv = v[r][j][q]; const f32x2 h2 = (f32x2){hv, hv};
                    d2[r][0] += h2 * (f32x2){w0[0], w0[1]}; d2[r][1] += h2 * (f32x2){w0[2], w0[3]}; d2[r][2] += h2 * (f32x2){w1[0], w1[1]}; d2[r][3] += h2 * (f32x2){w1[2], w1[3]}; } }
#pragma unroll
        for (int r = 0; r < NR; ++r) { const int i = i0 + r, row = row0 + i;
            const float d[8] = {d2[r][0][0], d2[r][0][1], d2[r][1][0], d2[r][1][1], d2[r][2][0], d2[r][2][1], d2[r][3][0], d2[r][3][1]};
            const float tot = reduce8(d, lane) + bias_e;
            if (MODE == 1) {
                if (lane < 8) { const float z = tot; logf[(size_t)row * 8 + eidx] = fminf(z, 0.f) - __logf(1.0f + __expf(-fabsf(z))); }
            } else {
                float dd[8];
#pragma unroll
                for (int e = 0; e < 8; ++e) dd[e] = __int_as_float(__builtin_amdgcn_readlane(__float_as_int(tot), (e >> 2) | (((e >> 1) & 1) << 1) | ((e & 1) << 2)));
                int e0 = 0; float v0 = dd[0];
#pragma unroll
                for (int e = 1; e < 8; ++e) if (dd[e] > v0) { v0 = dd[e]; e0 = e; }
                int e1 = -1; float v1 = -INFINITY;
#pragma unroll
                for (int e = 0; e < 8; ++e) if (e != e0 && dd[e] > v1) { v1 = dd[e]; e1 = e; }
                if (lane == 0) { const float w1 = 1.0f / (1.0f + __expf(v0 - v1)), w0 = 1.0f - w1; toke[row] = e0 | (e1 << 8); *(f32x2*)(tokw + (size_t)row * 2) = (f32x2){w0, w1}; tokE[wave * 16 + i] = e0 | (e1 << 8); }
            }
        }
    }
}
template <int MODE, bool XBF, int OUTK>
__device__ __forceinline__ void norm_phase(LAS unsigned char* lds, int bid, int tid, int wave, int lane, const float* xin, const bf16_t* xbin, const float* gvec, const float* scv, const float* shv,
                                           bf16_t* H, unsigned char* H8, float* SA, const float* W8src, int w8pitch, const float* b8, float* logf, int* toke, float* tokw, int* cnt) {
    LAS float* W8 = (LAS float*)lds;
    LAS int* tokE = (LAS int*)(lds + 32768);
    LAS int* cnts = tokE + 128;
    const int row0 = bid * 128 + wave * 16, b = row0 >> 11;
    constexpr int NR = (MODE == 0) ? 4 : 2;
    constexpr int NBUF = (MODE == 0) ? 3 : (MODE == 2 ? 3 : (XBF ? 4 : 2)), NBATCH = 16 / NR;
    typename NormRaw<XBF>::T raw[NBUF][NR][4];
#pragma unroll
    for (int bb = 0; bb < NBUF - 1; ++bb) norm_load<NR, XBF>(raw[bb], xin, xbin, row0 + bb * NR, lane);
    if (MODE != 0) { for (int i = tid; i < 8192; i += 512) W8[i] = W8src[(size_t)(i >> 3) * w8pitch + (i & 7)]; if (tid < 16) cnts[tid] = 0; LDS_WAIT(); __syncthreads(); }
    f32x4 gm[4], sh[4];
#pragma unroll
    for (int j = 0; j < 4; ++j) { const int c = 4 * lane + 256 * j; const f32x4 g = *(const f32x4*)(gvec + c), s = *(const f32x4*)(scv + (size_t)b * 6144 + c); gm[j] = g * (1.0f + s); sh[j] = *(const f32x4*)(shv + (size_t)b * 6144 + c); }
    const int eidx = 4 * (lane & 1) + 2 * ((lane >> 1) & 1) + ((lane >> 2) & 1);
    float bias_e = 0.f; if (MODE != 0) bias_e = b8[eidx];
#pragma unroll
    for (int bb = 0; bb < NBATCH; ++bb) {
        if (bb + NBUF - 1 < NBATCH) norm_load<NR, XBF>(raw[(bb + NBUF - 1) % NBUF], xin, xbin, row0 + (bb + NBUF - 1) * NR, lane);
        norm_proc<MODE, NR, OUTK, XBF>(raw[bb % NBUF], gm, sh, H, H8, SA, row0, bb * NR, wave, lane, W8, tokE, eidx, bias_e, logf, toke, tokw);
    }
    if (MODE == 2) {
        LDS_WAIT(); __syncthreads();
        if (tid < 128) { const int ee = tokE[tid]; const int e0 = ee & 255, e1 = ee >> 8;
#pragma unroll
            for (int e = 0; e < 8; ++e) { const unsigned long long m0 = __ballot(e0 == e), m1 = __ballot(e1 == e);
                if (lane == 0) { __hip_atomic_fetch_add(&cnts[e], (int)__popcll(m0), __ATOMIC_RELAXED, __HIP_MEMORY_SCOPE_WORKGROUP); __hip_atomic_fetch_add(&cnts[8 + e], (int)__popcll(m1), __ATOMIC_RELAXED, __HIP_MEMORY_SCOPE_WORKGROUP); } } }
        LDS_WAIT(); __syncthreads();
        if (tid < 16) cnt[bid * 16 + tid] = cnts[tid];
        LDS_WAIT(); __syncthreads();
    }
}

template <int HALFSEL>
__device__ __forceinline__ void final_phase(int bid, int wave, int lane, float* out, const bf16_t* xb, bf16_t* tmpx, const float* g, const float* gate, const int* LS, const float* tokw, const float* slab) {
    constexpr int ROWS = (HALFSEL == 2) ? 16 : 8;
    const int lrow0 = bid * (8 * ROWS) + wave * ROWS; f32x4 gm[4];
#pragma unroll
    for (int j = 0; j < 4; ++j) gm[j] = *(const f32x4*)(g + 4 * lane + 256 * j);
    const bf16_t* src = HALFSEL == 1 ? tmpx : xb; const int rbase = HALFSEL == 1 ? 16384 : 0;
    for (int i0 = 0; i0 < ROWS; i0 += 4) { f32x4 v[4][4]; u32x2 cp[4][4];
#pragma unroll
        for (int r = 0; r < 4; ++r) { const GAS u32x2* xr = (const GAS u32x2*)(src + (size_t)(lrow0 + i0 + r) * 1024) + lane;
#pragma unroll
            for (int j = 0; j < 4; ++j) { const u32x2 w = xr[64 * j]; v[r][j] = (f32x4){bf_lo(w.x), bf_hi(w.x), bf_lo(w.y), bf_hi(w.y)}; }
            if (HALFSEL == 0) { const GAS u32x2* xc = (const GAS u32x2*)(xb + (size_t)(16384 + lrow0 + i0 + r) * 1024) + lane;
#pragma unroll
                for (int j = 0; j < 4; ++j) cp[r][j] = xc[64 * j]; } }
#pragma unroll
        for (int r = 0; r < 4; ++r) { const int row = rbase + lrow0 + i0 + r, b = row >> 11;
            if (HALFSEL == 0) { GAS u32x2* tc = (GAS u32x2*)(tmpx + (size_t)(lrow0 + i0 + r) * 1024) + lane;
#pragma unroll
                for (int j = 0; j < 4; ++j) tc[64 * j] = cp[r][j]; }
#pragma unroll
            for (int k = 0; k < 2; ++k) { const int ls = __builtin_amdgcn_readfirstlane(__hip_atomic_load(LS + (size_t)row * 2 + k, RLX_AGENT));
                if (ls >= 0) { const float w = __hip_atomic_load(tokw + (size_t)row * 2 + k, RLX_AGENT);
#pragma unroll
                    for (int j = 0; j < 4; ++j) { const int c = 4 * lane + 256 * j; const f32x4 gt = *(const f32x4*)(gate + (size_t)b * 6144 + c);
                        const f32x4 s0 = *(const f32x4*)(slab + (size_t)ls * 1024 + c);
                        v[r][j] += (gt * w) * s0; } } }
            float ss = 0.f;
#pragma unroll
            for (int j = 0; j < 4; ++j) ss += (v[r][j].x * v[r][j].x + v[r][j].y * v[r][j].y) + (v[r][j].z * v[r][j].z + v[r][j].w * v[r][j].w);
            const float rstd = 1.0f / sqrtf(wave_sum(ss) * (1.0f / 1024.0f) + EPS_RMS);
            GAS f32x4* orow = (GAS f32x4*)(out + (size_t)row * 1024) + lane;
#pragma unroll
            for (int j = 0; j < 4; ++j) orow[64 * j] = v[r][j] * rstd * gm[j]; } }
}

__device__ __forceinline__ void cumsum_bh(int b, int h, int lane, const float* logf, float* Fl2) {
    float pref[32]; float s = 0.f; const int t0 = 32 * lane;
#pragma unroll
    for (int i = 0; i < 32; ++i) { s += logf[((size_t)b * 2048 + t0 + i) * 8 + h]; pref[i] = s; }
    float incl = s;
#pragma unroll
    for (int o = 1; o < 64; o <<= 1) { const float n = __shfl_up(incl, o); if (lane >= o) incl += n; }
    const float excl = incl - s; float* out = Fl2 + (size_t)(b * 8 + h) * 2048 + t0;
#pragma unroll
    for (int i = 0; i < 32; i += 4) *(f32x4*)(out + i) = (f32x4){(excl + pref[i]) * LOG2E, (excl + pref[i + 1]) * LOG2E, (excl + pref[i + 2]) * LOG2E, (excl + pref[i + 3]) * LOG2E};
}

__device__ __forceinline__ void scan_item(int g, int b, int lane, const float* Sloc, bf16_t* AU, const float* A32l) {
    const f32x2 a = *(const f32x2*)(A32l + (size_t)(g * 64 + lane) * 2); float sr = 0.f, si = 0.f;
    const size_t row0 = (size_t)g * 1024 + (size_t)b * 64;
    for (int c0 = 0; c0 < 64; c0 += 8) { f32x2 loc[8];
#pragma unroll
        for (int j = 0; j < 8; ++j) loc[j] = *(const f32x2*)(Sloc + (row0 + c0 + j) * 128 + 2 * lane);
#pragma unroll
        for (int j = 0; j < 8; ++j) { *(GAS unsigned*)(AU + (row0 + c0 + j) * 640 + 512 + 2 * lane) = cvt_pk_bf16(sr, si);
            const float nr = a.x * sr - a.y * si + loc[j].x, ni = a.x * si + a.y * sr + loc[j].y; sr = nr; si = ni; } }
}

__device__ __forceinline__ void sort_phase(LAS unsigned char* lds, int bid, int tid, int lane, const int* toke, const float* tokw, const int* cnt, unsigned char* sortb, int* LS) {
    LAS int* call = (LAS int*)lds;
    LAS int* offs = call + 4096;
    LAS int* tot = offs + 16;
    LAS int* w0c = tot + 16;
    int* rowlist = (int*)(sortb + SORT_ROWLIST); float* slotw = (float*)(sortb + SORT_SLOTW); int* pexp = (int*)(sortb + SORT_PEXP); int* np = (int*)(sortb + SORT_NP);
    for (int i = tid; i < 4096; i += 512) call[i] = __hip_atomic_load(cnt + i, RLX_AGENT);
    LDS_WAIT(); __syncthreads();
    if (tid < 16) { int before = 0, total = 0; for (int w = 0; w < 256; ++w) { const int c = call[w * 16 + tid]; if (w < bid) before += c; total += c; } offs[tid] = before; tot[tid] = total; }
    LDS_WAIT(); __syncthreads();
    if (tid < 16) { const int k = tid >> 3, e = tid & 7; int base = 0; for (int e2 = 0; e2 < e; ++e2) base += (tot[k * 8 + e2] + 255) & ~255; offs[tid] += base; }
    LDS_WAIT(); __syncthreads();
    int ee = 0, e0 = 0, e1 = 0, r0 = 0, r1 = 0;
    if (tid < 128) { ee = __hip_atomic_load(toke + bid * 128 + tid, RLX_AGENT); e0 = ee & 255; e1 = ee >> 8;
#pragma unroll
        for (int e = 0; e < 8; ++e) { const unsigned long long m0 = __ballot(e0 == e), m1 = __ballot(e1 == e); const unsigned long long lt = (1ull << lane) - 1ull;
            if (e0 == e) r0 = (int)__popcll(m0 & lt); if (e1 == e) r1 = (int)__popcll(m1 & lt);
            if (tid < 64 && lane == 0) { w0c[e] = (int)__popcll(m0); w0c[8 + e] = (int)__popcll(m1); } } }
    LDS_WAIT(); __syncthreads();
    if (tid < 128) { if (tid >= 64) { r0 += w0c[e0]; r1 += w0c[8 + e1]; }
        const int token = bid * 128 + tid; const int s0 = offs[e0] + r0, s1 = offs[8 + e1] + r1;
        const float w0 = __hip_atomic_load(tokw + (size_t)token * 2, RLX_AGENT), w1 = __hip_atomic_load(tokw + (size_t)token * 2 + 1, RLX_AGENT);
        rowlist[s0] = token; slotw[s0] = w0; rowlist[SLOT_CAP + s1] = token; slotw[SLOT_CAP + s1] = w1;
        int n0 = 0;
#pragma unroll
        for (int e = 0; e < 8; ++e) n0 += (tot[e] + 255) >> 8;
        LS[token * 2] = (s0 >> 8) >= 128 ? (((s0 >> 8) - 128) << 8) + (s0 & 255) : -1;
        LS[token * 2 + 1] = (s1 >> 8) >= 128 ? (((n0 - 128) + (s1 >> 8) - 128) << 8) + (s1 & 255) : -1; }
    if (bid == 0) {
        if (tid < 16) { const int k = tid >> 3, e = tid & 7; int base = 0; for (int e2 = 0; e2 < e; ++e2) base += (tot[k * 8 + e2] + 255) & ~255;
            const int t = tot[tid], pe = (t + 255) & ~255;
            for (int s = base + t; s < base + pe; ++s) { rowlist[k * SLOT_CAP + s] = -1; slotw[k * SLOT_CAP + s] = 0.f; }
            for (int p = base >> 8; p < (base + pe) >> 8; ++p) pexp[k * 136 + p] = e;
            if (e == 7) np[k] = (base + pe) >> 8; }
        if (tid == 0) {
            int* panel = (int*)(sortb + SORT_PANEL); int* npc = (int*)(sortb + SORT_NPC); int n0 = 0, n1 = 0;
            for (int e = 0; e < 8; ++e) { n0 += (tot[e] + 255) >> 8; n1 += (tot[8 + e] + 255) >> 8; }
            for (int p = 0; p < 128; ++p) { panel[p] = p; panel[136 + p] = 136 + p; }
            int c = 0; for (int p = 128; p < n0; ++p) panel[272 + c++] = p; for (int p = 128; p < n1; ++p) panel[272 + c++] = 136 + p;
            npc[0] = 128; npc[1] = 128; npc[2] = c;
            int* panelm = (int*)(sortb + SORT_PANELM); for (int p = 0; p < 128; ++p) panelm[p] = 136 + p; for (int i = 0; i < c; ++i) panelm[128 + i] = panel[272 + i];
            *(int*)(sortb + SORT_NPM) = 128 + c; } }
    LDS_WAIT(); __syncthreads();
}

#ifndef MK_MULTI
#define MK_MULTI 0
#endif
constexpr int LSTRIDE = 18, NPHASE = 3 + 2 * LSTRIDE, PH_FINAL = 1 + 2 * LSTRIDE;
struct Args { const float* in[31]; float* out; unsigned char* ws; int ph_lo, ph_hi, aux, pad; };
static_assert(sizeof(Args) == 31 * 8 + 8 + 8 + 16, "Args has no padding");

#ifndef PHASE_MASK
#define PHASE_MASK 0xFFFFFFFFu
#endif
#define HAVE(j) ((PHASE_MASK >> (j)) & 1u)
#define IN(k) (lo <= (k) && (k) < hi)
#define INP(i) ((const float*)ld_ptr(PT, (i)))
#define WSP(T, off) ((T*)((unsigned char*)ld_ptr(PT, 32) + (off)))
#define XRES ((float*)ld_ptr(PT, 31))
#define XBP WSP(bf16_t, WS_XB)
#define WUP8P ((unsigned char*)ld_ptr(PT, 31))
#define SEAM(k) do { if (IN(k) && IN((k) + 1)) { XcdBarrier bar_; bar_.bar = WSP(unsigned, WS_CTL) + CW_BAR; bar_.x = xb_xcc_id(); bar_.st = MISC + 8; xcd_barrier(bar_); } } while (0)
#define IDS int tid = threadIdx.x, bid = blockIdx.x, G = gridDim.x; asm volatile("" : "+v"(tid), "+s"(bid), "+s"(G)); \
    const int lane = tid & 63, wave = __builtin_amdgcn_readfirstlane(tid >> 6); const int vcu = (G % 8 == 0) ? (bid % 8) * (G / 8) + bid / 8 : bid; \
    const int gw = vcu * NWAVES + wave, NGW = G * NWAVES; (void)lane; (void)gw; (void)NGW; (void)vcu

template <int l>
__device__ __forceinline__ void layer_phases(LAS unsigned char* lds, unsigned char* lds_raw, LAS unsigned long long* PT, volatile LAS unsigned* MISC, const int lo, const int hi, const int args_aux) {

        constexpr int P = 1 + LSTRIDE * l;
#undef ADA_L
#define ADA_L (WSP(float, WS_ADA) + (size_t)l * 16 * 6144)
#undef XCUR
#define XCUR ((l == 0) ? INP(0) : (const float*)XRES)
        if (HAVE(0) && IN(P + 0)) { IDS; const float* ada_l = ADA_L;
            if (l == 0) {
                if (bid < 64) { const int ll = bid >> 5, g = bid & 31; const size_t lg = (size_t)ll * 32 + g;
                    s5_gen(lds, tid, INP(8) + lg * 64, INP(9) + lg * 64, INP(10) + lg, INP(11) + lg * 1024, INP(12) + lg * 1024, INP(13) + lg * 1024, INP(14) + lg * 1024,
                           WSP(bf16_t, WS_TG) + lg * 512 * 640, WSP(bf16_t, WS_WST) + lg * 256 * 512, WSP(float, WS_A32) + lg * 128);
                } else {
                    const P0Ptrs PP{INP(5), INP(16), INP(18), INP(19), INP(20), INP(22), INP(23), INP(24), WSP(bf16_t, WS_WIN), WSP(bf16_t, WS_WGLU), WSP(bf16_t, WS_WPA), WSP(bf16_t, WS_WPS), WSP(bf16_t, WS_WOUT), WSP(bf16_t, WS_WUPD), WSP(bf16_t, WS_WDND), WSP(float, WS_CTL) + CW_CMAX};
                    TR_LOOP((bid - 64) * NWAVES + wave, TI_P0, (G - 64) * NWAVES, make_p0_item, PP);
                }
                __syncthreads();
            }
            norm_phase<1, (l != 0), 2>(lds, bid, tid, wave, lane, INP(0), XBP, INP(4) + l * 1024, ada_l + 1024, ada_l, nullptr, WSP(unsigned char, WS_Y), WSP(float, WS_SA1), INP(5) + (size_t)l * 1024 * NIN_SRC + 1536, NIN_SRC, INP(6) + l * 8, WSP(float, WS_LOGF), nullptr, nullptr, nullptr); }
        SEAM(P + 0);
        if (HAVE(1) && IN(P + 1)) { IDS;
            {
                pg8::ProbPlainI8 S{WSP(bf16_t, WS_Y), WSP(bf16_t, WS_WIN) + (size_t)l * WIN_LSTRIDE, 512, 512, 512, {}}; S.ord.init(128, 16, G, bid);
                pg8::EpiIn<true> E{WSP(bf16_t, WS_Q), WSP(bf16_t, WS_AU), WSP(bf16_t, WS_GATES), INP(7) + l * 2048, 0, WSP(float, WS_SA1), WSP(unsigned, WS_CTL) + CW_CMAX + l * 4096};
                pg8::gemm_phase<pg8::EpiIn<true>, pg8::ProbPlainI8, true>(lds, S, E); }
        }
        SEAM(P + 1);
        if (HAVE(2) && IN(P + 2)) { IDS;
            if (bid >= G - 16) cumsum_bh(bid - (G - 16), wave, lane, WSP(float, WS_LOGF), WSP(float, WS_FL2));
            if (bid >= 128 && bid < 240) { const MoePtrs MP{INP(27), INP(28), INP(29), nullptr, WSP(bf16_t, WS_WDNM), WUP8P};
                const int r0 = (l * 112 + (bid - 128)) * MOE_R_S5; TR_LOOP(r0 * 8 + wave, (r0 + MOE_R_S5) * 8, 8, make_moe_item, MP); }
            pg8::ProbS5b S{WSP(bf16_t, WS_AU), WSP(bf16_t, WS_WST) + (size_t)l * 32 * 256 * 512, 512, 640, 512, {}}; S.ord.init(128, 1, G, bid);
            pg8::EpiS5b E{WSP(float, WS_SLOC)};
            pg8::gemm_phase<pg8::EpiS5b, pg8::ProbS5b, false>(lds, S, E);
            { pg8::Unit u0; if (S.ord.next(0, u0)) { VM_WAIT(); __syncthreads();
                if (wave < 4) scan_item(u0.pm >> 2, (u0.pm & 3) * 4 + wave, lane, WSP(float, WS_SLOC), WSP(bf16_t, WS_AU), WSP(float, WS_A32) + (size_t)l * 32 * 128); } }
        }
        SEAM(P + 2);
        if (HAVE(4) && IN(P + 4)) { IDS;
            pg8::ProbS5ad S{WSP(bf16_t, WS_AU), WSP(bf16_t, WS_TG) + (size_t)l * 32 * 512 * 640, 640, 640, 640, {}}; S.ord.init(128, 2, G, bid);
            pg8::EpiS5ad E{WSP(bf16_t, WS_AU), WSP(bf16_t, WS_Y), INP(15) + l * 512};
            pg8::gemm_phase<pg8::EpiS5ad, pg8::ProbS5ad, false>(lds, S, E);
        }
        SEAM(P + 4);
        if (HAVE(5) && IN(P + 5)) { IDS;
            pg8::ProbPlain S{WSP(bf16_t, WS_Y), WSP(bf16_t, WS_WGLU) + (size_t)l * 512 * 512, 512, 512, 512, {}}; S.ord.init(128, 2, G, bid);
            pg8::EpiGlu E{WSP(bf16_t, WS_Y), WSP(bf16_t, WS_Y2), INP(17) + l * 512};
            pg8::gemm_phase<pg8::EpiGlu, pg8::ProbPlain, false>(lds, S, E);
        }
        if (HAVE(6) && IN(P + 6)) { IDS;
            const attn_body::AttnTensors AT{WSP(const attn_body::bf16, WS_Q), WSP(const attn_body::bf16, WS_K), WSP(const attn_body::bf16, WS_V), (args_aux == 1) ? WSP(attn_body::bf16, WS_Y) : WSP(attn_body::bf16, WS_Q), WSP(const float, WS_FL2)};
            const attn_body::StaticOrder S(G, bid);
            attn_body::attn_phase<attn_body::StaticOrder>((char*)lds_raw, AT, S);
        }
        SEAM(P + 6);
        if (HAVE(7) && IN(P + 7)) { IDS;
            pg8::ProbProj2 S{WSP(bf16_t, WS_Q), (long)WS_Y2 - (long)WS_Q, WSP(bf16_t, WS_WPA) + (size_t)l * 1024 * 512, (long)WS_WPS - (long)WS_WPA, 512, 512, 512, {}}; S.ord.init(128, 4, G, bid);
            pg8::EpiProj2 E{WSP(bf16_t, WS_GATES), WSP(bf16_t, WS_MIX)};
            pg8::gemm_phase<pg8::EpiProj2, pg8::ProbProj2, true>(lds, S, E);
        }
        SEAM(P + 7);
        if (HAVE(9) && IN(P + 9)) { IDS;
            pg8::ProbPlain S{WSP(bf16_t, WS_MIX), WSP(bf16_t, WS_WOUT) + (size_t)l * 1024 * 1024, 1024, 1024, 1024, {}}; S.ord.init(128, 4, G, bid);
            pg8::EpiOut<(l == 0)> E{INP(0), XBP, ADA_L + 2 * 1024, args_aux == 1 ? 0.f : 1.f};
            pg8::gemm_phase<pg8::EpiOut<(l == 0)>, pg8::ProbPlain, true>(lds, S, E);
        }
        SEAM(P + 9);
        if (HAVE(10) && IN(P + 10)) { IDS; const float* ada_l = ADA_L;
            if (l == 0) norm_phase<0, true, 2>(lds, bid, tid, wave, lane, nullptr, XBP, INP(21) + l * 1024, ada_l + 4 * 1024, ada_l + 3 * 1024, nullptr, WSP(unsigned char, WS_H8), WSP(float, WS_SA2), nullptr, 0, nullptr, nullptr, nullptr, nullptr, nullptr);
            else { unsigned char* SORTB = WSP(unsigned char, WS_SORT);
                norm_phase<2, true, 3>(lds, bid, tid, wave, lane, nullptr, XBP, INP(21) + l * 1024, ada_l + 4 * 1024, ada_l + 3 * 1024, nullptr, WSP(unsigned char, WS_H8), nullptr, INP(25), 8, INP(26), nullptr, WSP(int, WS_TOKE), WSP(float, WS_TOKW), (int*)(SORTB + SORT_CNT));
                const MoePtrs MP{INP(27), INP(28), INP(29), nullptr, WSP(bf16_t, WS_WDNM), WUP8P};
                { const int r0 = MOE_R_NORM0 + vcu * MOE_R_NORM_EACH; TR_LOOP(r0 * 8 + wave, (r0 + MOE_R_NORM_EACH) * 8, 8, make_moe_item, MP); }
                if (MOE_R_TAIL0 + vcu < MOE_ROUNDS) { const int it9 = (MOE_R_TAIL0 + vcu) * 8 + wave; TR_LOOP(it9, it9 + 1, 8, make_moe_item, MP); } }
        }
        SEAM(P + 10);
        if (HAVE(11) && IN(P + 11) && l == 1) { IDS;
            { unsigned char* SORTB = WSP(unsigned char, WS_SORT); sort_phase(lds, bid, tid, lane, WSP(int, WS_TOKE), WSP(float, WS_TOKW), (int*)(SORTB + SORT_CNT), SORTB, WSP(int, WS_LS)); }
            if (bid != 0) { const MoePtrs MP{INP(27), INP(28), INP(29), nullptr, WSP(bf16_t, WS_WDNM), WUP8P};
                const int it1 = (MOE_R_SORT0 + bid - 1) * 8 + wave; TR_LOOP(it1, it1 + 1, 8, make_moe_item, MP); }
        }
        if (l == 1) SEAM(P + 11);
        for (int k = 0; k < (l == 0 ? 1 : 3); ++k) {
            if (HAVE(12) && IN(P + 12 + 2 * k) && !(l == 1 && k == 2)) { IDS;
                unsigned char* SORTB = WSP(unsigned char, WS_SORT);
                const int np = __builtin_amdgcn_readfirstlane(__hip_atomic_load((l == 1 && k == 1) ? (int*)(SORTB + SORT_NPM) : (int*)(SORTB + SORT_NPC) + k, RLX_AGENT));
                if (l == 1) {
                    pg8::ProbUp8 S{WSP(bf16_t, WS_H8), (bf16_t*)WUP8P, (int*)(SORTB + SORT_ROWLIST), (int*)(SORTB + SORT_PEXP), (k == 1) ? (int*)(SORTB + SORT_PANELM) : (int*)(SORTB + SORT_PANEL) + k * 136, 512, 512, 512, {}}; S.ord.init(np, 22, G, bid);
                    pg8::EpiUp<true, false> E{WSP(bf16_t, WS_HID), nullptr, nullptr};
                    pg8::gemm_phase<pg8::EpiUp<true, false>, pg8::ProbUp8, true>(lds, S, E);
                } else {
                    pg8::ProbPlainI8 S{WSP(bf16_t, WS_H8), WSP(bf16_t, WS_WUPD), 512, 512, 512, {}}; S.ord.init(128, 22, G, bid);
                    pg8::EpiUp<(DENSE_DOWN_FP8 != 0), true> E{WSP(bf16_t, WS_HID), WSP(float, WS_SA2), WSP(unsigned, WS_CTL) + CW_CMAX + 8192};
                    pg8::gemm_phase<pg8::EpiUp<(DENSE_DOWN_FP8 != 0), true>, pg8::ProbPlainI8, true>(lds, S, E);
                }
            }
            if (!(l == 1 && k == 2)) SEAM(P + 12 + 2 * k);
            if (HAVE(13) && IN(P + 13 + 2 * k)) { IDS;
                unsigned char* SORTB = WSP(unsigned char, WS_SORT);
                const int np = __builtin_amdgcn_readfirstlane(__hip_atomic_load((int*)(SORTB + SORT_NPC) + k, RLX_AGENT));
                if (l == 0 && !DENSE_DOWN_FP8) {
                    pg8::ProbDown S{WSP(bf16_t, WS_HID), WSP(bf16_t, WS_WDND), (int*)(SORTB + SORT_PEXP), (int*)(SORTB + SORT_PANEL) + k * 136, DFF, DFF, DFF, {}}; S.ord.init(np, 4, G, bid);
                    pg8::EpiDown E{XBP, ADA_L + 5 * 1024, (int*)(SORTB + SORT_ROWLIST), (float*)(SORTB + SORT_SLOTW), (int*)(SORTB + SORT_PANEL) + k * 136, args_aux == 1 ? 0.f : 1.f};
                    pg8::gemm_phase<pg8::EpiDown, pg8::ProbDown, true>(lds, S, E);
                } else if (k < 2) {
                    pg8::ProbDown8 S{WSP(bf16_t, WS_HID), (l == 0) ? WSP(bf16_t, WS_WDND) : WSP(bf16_t, WS_WDNM), (int*)(SORTB + SORT_PEXP), (int*)(SORTB + SORT_PANEL) + k * 136, DFF / 2, DFF / 2, DFF / 2, {}}; S.ord.init(np, 4, G, bid);
                    pg8::EpiDown E{XBP, ADA_L + 5 * 1024, (int*)(SORTB + SORT_ROWLIST), (float*)(SORTB + SORT_SLOTW), (int*)(SORTB + SORT_PANEL) + k * 136, args_aux == 1 ? 0.f : 1.f};
                    pg8::gemm_phase<pg8::EpiDown, pg8::ProbDown8, true>(lds, S, E);
                } else {
                    pg8::ProbDown8 S{WSP(bf16_t, WS_HID + (size_t)128 * 256 * DFF), WSP(bf16_t, WS_WDNM), (int*)(SORTB + SORT_PEXP), (int*)(SORTB + SORT_PANEL) + k * 136, DFF / 2, DFF / 2, DFF / 2, {}}; S.ord.init(np, 4, G, bid);
                    pg8::EpiSlab E{WSP(float, WS_SL)};
                    pg8::gemm_phase<pg8::EpiSlab, pg8::ProbDown8, false>(lds, S, E);
                }
            }
            SEAM(P + 13 + 2 * k);
        }
    }

__global__ void __launch_bounds__(NWAVES * 64, 2) fwd_kernel(Args args) {
    extern __shared__ __attribute__((aligned(16))) unsigned char lds_raw[];
    LAS unsigned char* lds = (LAS unsigned char*)lds_raw;
    volatile LAS unsigned* MISC = (volatile LAS unsigned*)(lds + MISC_OFF);
    const int tid0 = threadIdx.x;
    for (int u = tid0; u < (LDS_BYTES - LDSCTL_OFF) / 4; u += NWAVES * 64) ((LAS unsigned*)(lds + LDSCTL_OFF))[u] = 0u;
    __syncthreads();
    const int lo = args.ph_lo, hi = args.ph_hi;
    if (hi - lo > 1) (void)xcd_barrier_post((unsigned*)(args.ws + WS_CTL) + CW_BAR, MISC + 8);

    LAS unsigned long long* PT = (LAS unsigned long long*)(lds + LDSCTL_OFF + 1024);
    if (tid0 < 31) PT[tid0] = (unsigned long long)args.in[tid0];
    if (tid0 == 31) PT[31] = (unsigned long long)args.out;
    if (tid0 == 32) PT[32] = (unsigned long long)args.ws;
    LDS_WAIT(); __syncthreads();

    if (HAVE(16) && IN(0)) { IDS;
        for (int it = G - 1 - bid; it < CM_ITEMS; it += G) {
            float* CM = WSP(float, WS_CTL) + CW_CMAX;
            if (it < 128) { const int l = it >> 6, n0 = 64 * (it & 63); colmax_item(lds, tid, INP(5) + (size_t)l * 1024 * NIN_SRC, NIN_SRC, n0 < 1536 ? n0 : n0 + 8, CM + l * 4096 + n0); }
            else { const int r = it - 128, which = r / 44, nb = r % 44; colmax_item(lds, tid, which ? INP(23) : INP(22), DFF, 64 * nb, CM + 8192 + up_row(64 * nb, which)); } }
        for (int it = bid; it < 192; it += G) { const int l = it / 96, cg = it % 96; ada_item(lds, tid, INP(1), INP(2) + (size_t)l * 1024 * 6144, INP(3) + (size_t)l * 6144, WSP(float, WS_ADA) + (size_t)l * 16 * 6144, cg); }
        { unsigned char* SORTB = WSP(unsigned char, WS_SORT); int* ROWLIST = (int*)(SORTB + SORT_ROWLIST); float* SLOTW = (float*)(SORTB + SORT_SLOTW); int* PEXP = (int*)(SORTB + SORT_PEXP); int* NP = (int*)(SORTB + SORT_NP);
          for (int i = bid * 512 + tid; i < TOK; i += G * 512) { ROWLIST[i] = i; SLOTW[i] = 1.0f; }
          if (bid == 0 && tid < 136) { PEXP[tid] = 0; ((int*)(SORTB + SORT_PANEL))[tid] = tid; }
          if (bid == 0 && tid == 0) { NP[0] = 128; ((int*)(SORTB + SORT_NPC))[0] = 128; } }
    }
    SEAM(0);

    layer_phases<0>(lds, lds_raw, PT, MISC, lo, hi, args.aux);
    layer_phases<1>(lds, lds_raw, PT, MISC, lo, hi, args.aux);
    if (HAVE(17) && IN(PH_FINAL)) { IDS; final_phase<2>(bid, wave, lane, XRES, XBP, nullptr, INP(30), WSP(float, WS_ADA) + (size_t)16 * 6144 + 5 * 1024, WSP(int, WS_LS), WSP(float, WS_TOKW), WSP(float, WS_SL)); }
}

extern "C" void kernel_launch(void* const* d_in, const int* in_sizes, int n_in, void* d_out, int out_size, void* d_ws, size_t ws_size, hipStream_t stream) {
    static int grid = 0;
    if (grid == 0) {
        if (n_in != 31 || out_size != TOK * DMODEL || ws_size < WS_END) { fprintf(stderr, "kernel_launch: unexpected problem (n_in %d out %d ws %zu)\n", n_in, out_size, ws_size); grid = -1; return; }
        int dev = 0, cus = 0, per_cu = 0;
        if (hipGetDevice(&dev) != hipSuccess || hipDeviceGetAttribute(&cus, hipDeviceAttributeMultiprocessorCount, dev) != hipSuccess) { grid = -1; return; }
        if (hipFuncSetAttribute((const void*)fwd_kernel, hipFuncAttributeMaxDynamicSharedMemorySize, LDS_BYTES) != hipSuccess) { fprintf(stderr, "kernel_launch: hipFuncSetAttribute failed\n"); grid = -1; return; }
        if (hipOccupancyMaxActiveBlocksPerMultiprocessor(&per_cu, (const void*)fwd_kernel, NWAVES * 64, LDS_BYTES) != hipSuccess || per_cu < 1) fprintf(stderr, "kernel_launch: occupancy query reports %d\n", per_cu);
        (void)hipGetLastError();
        grid = cus < 256 ? cus : 256;
    }
    if (grid < 0) return;
    if (hipMemsetAsync((char*)d_ws + WS_CTL, 0, CTL_ZERO_BYTES, stream) != hipSuccess) return;
    Args a{};
    for (int i = 0; i < 31; ++i) a.in[i] = (const float*)d_in[i];
    a.out = (float*)d_out; a.ws = (unsigned char*)d_ws;
#if MK_MULTI
#ifndef LAST_PHASE
#define LAST_PHASE (NPHASE - 1)
#endif
#ifdef DUMP_OFF
#endif
    for (int p = 0; p <= LAST_PHASE; ++p) { if (p == 12 || (p >= 15 && p <= 18)) continue; a.ph_lo = p; a.ph_hi = p + 1;
#ifdef REP_LIST
        { const int reps[] = REP_LIST; for (int r : reps) if (r == p) { a.aux = 1; hipLaunchKernelGGL(fwd_kernel, dim3(grid), dim3(NWAVES * 64), LDS_BYTES, stream, a); a.aux = 0; } }
#endif
        hipLaunchKernelGGL(fwd_kernel, dim3(grid), dim3(NWAVES * 64), LDS_BYTES, stream, a); }
#ifdef DUMP_OFF
    a.ph_lo = NPHASE; a.ph_hi = NPHASE + 1; hipLaunchKernelGGL(fwd_kernel, dim3(grid), dim3(NWAVES * 64), LDS_BYTES, stream, a);
#endif
#else
    a.ph_lo = 0; a.ph_hi = NPHASE;
    hipLaunchKernelGGL(fwd_kernel, dim3(grid), dim3(NWAVES * 64), LDS_BYTES, stream, a);
#endif
}
```

```cpp
#define DENSE_DOWN_FP8 1
#include <hip/hip_runtime.h>
#include <hip/hip_bf16.h>
#include <cstdio>
#include <cstdint>
#include <cmath>

#ifndef DENSE_DOWN_FP8
#define DENSE_DOWN_FP8 0
#endif
#define GAS __attribute__((address_space(1)))
#define LAS __attribute__((address_space(3)))
typedef unsigned short bf16_t;
typedef short bf16x8 __attribute__((ext_vector_type(8)));
typedef float f32x4 __attribute__((ext_vector_type(4)));
typedef float f32x2 __attribute__((ext_vector_type(2)));
typedef unsigned u32x4 __attribute__((ext_vector_type(4)));
typedef unsigned u32x2 __attribute__((ext_vector_type(2)));
#define RLX_AGENT __ATOMIC_RELAXED, __HIP_MEMORY_SCOPE_AGENT
#define LDS_WAIT() asm volatile("s_waitcnt lgkmcnt(0)" ::: "memory")
#define VM_WAIT() asm volatile("s_waitcnt vmcnt(0)" ::: "memory")

constexpr int TOK = 32768, DMODEL = 1024, NBATCH = 16, SEQL = 2048, NLAYER = 2;
constexpr int DFF = 2816, NEXP = 8, NIN_SRC = 4104;
constexpr float EPS_RMS = 1e-6f;
constexpr float LOG2E = 1.4426950408889634f;
constexpr float C2Q = 0.125f * 1.4426950408889634f;

typedef __bf16 bf16x2_t __attribute__((ext_vector_type(2)));
__device__ __forceinline__ unsigned cvt_pk_bf16(float lo, float hi) { f32x2 v = {lo, hi}; bf16x2_t b = __builtin_convertvector(v, bf16x2_t); return __builtin_bit_cast(unsigned, b); }
__device__ __forceinline__ float bf_lo(unsigned w) { return __uint_as_float(w << 16); }
__device__ __forceinline__ float bf_hi(unsigned w) { return __uint_as_float(w & 0xffff0000u); }
__device__ __forceinline__ float fast_sigmoid(float x) { return __builtin_amdgcn_rcpf(1.0f + __builtin_amdgcn_exp2f(-x * LOG2E)); }
__device__ __forceinline__ f32x4 exp2_4(const f32x4& t) { return (f32x4){__builtin_amdgcn_exp2f(t[0]), __builtin_amdgcn_exp2f(t[1]), __builtin_amdgcn_exp2f(t[2]), __builtin_amdgcn_exp2f(t[3])}; }
__device__ __forceinline__ f32x4 rcp_4(const f32x4& d) { return (f32x4){__builtin_amdgcn_rcpf(d[0]), __builtin_amdgcn_rcpf(d[1]), __builtin_amdgcn_rcpf(d[2]), __builtin_amdgcn_rcpf(d[3])}; }
__device__ __forceinline__ f32x4 sigmoid_4(const f32x4& x) { return rcp_4(exp2_4(x * (-LOG2E)) + 1.0f); }
__device__ __forceinline__ f32x4 silu_mul_4(const f32x4& a, const f32x4& b) { return (a * b) * sigmoid_4(a); }
__device__ __forceinline__ float gelu_tanh(float x) { const float u = x + 0.044715f * x * x * x; return x * __builtin_amdgcn_rcpf(1.0f + __builtin_amdgcn_exp2f(-1.5957691216f * LOG2E * u)); }
__device__ __forceinline__ unsigned f2bf(float f) { unsigned u = __builtin_bit_cast(unsigned, f); return (u + 0x7fffu + ((u >> 16) & 1u)) >> 16; }
__device__ __forceinline__ unsigned pk2(float lo, float hi) { return f2bf(lo) | (f2bf(hi) << 16); }
template <int CTRL, int ROWMASK, int BANKMASK> __device__ __forceinline__ float dpp_f(float old, float v) { return __int_as_float(__builtin_amdgcn_update_dpp(__float_as_int(old), __float_as_int(v), CTRL, ROWMASK, BANKMASK, false)); }
__device__ __forceinline__ float wave_sum(float v) {
    v += dpp_f<0xB1, 0xF, 0xF>(0.f, v); v += dpp_f<0x4E, 0xF, 0xF>(0.f, v); v += dpp_f<0x141, 0xF, 0xF>(0.f, v); v += dpp_f<0x140, 0xF, 0xF>(0.f, v);
    v += dpp_f<0x142, 0xA, 0xF>(0.f, v); v += dpp_f<0x143, 0xC, 0xF>(0.f, v);
    return __int_as_float(__builtin_amdgcn_readlane(__float_as_int(v), 63));
}
__device__ __forceinline__ float wave_max_nonneg(float v) {
    v = fmaxf(v, dpp_f<0xB1, 0xF, 0xF>(0.f, v)); v = fmaxf(v, dpp_f<0x4E, 0xF, 0xF>(0.f, v)); v = fmaxf(v, dpp_f<0x141, 0xF, 0xF>(0.f, v)); v = fmaxf(v, dpp_f<0x140, 0xF, 0xF>(0.f, v));
    v = fmaxf(v, dpp_f<0x142, 0xA, 0xF>(0.f, v)); v = fmaxf(v, dpp_f<0x143, 0xC, 0xF>(0.f, v));
    return __int_as_float(__builtin_amdgcn_readlane(__float_as_int(v), 63));
}
__device__ __forceinline__ float xor16_sum(float v) { const auto r = __builtin_amdgcn_permlane16_swap(__float_as_int(v), __float_as_int(v), false, false); return __int_as_float(r[0]) + __int_as_float(r[1]); }
__device__ __forceinline__ float xor32_sum(float v) { const auto r = __builtin_amdgcn_permlane32_swap(__float_as_int(v), __float_as_int(v), false, false); return __int_as_float(r[0]) + __int_as_float(r[1]); }

__device__ __forceinline__ unsigned pack_i8(float a, float b, float c, float d) {
    const unsigned ua = __float_as_uint(a + 12582912.f), ub = __float_as_uint(b + 12582912.f), uc = __float_as_uint(c + 12582912.f), ud = __float_as_uint(d + 12582912.f);
    const unsigned ab = __builtin_amdgcn_perm(ub, ua, 0x0c0c0400u), cd = __builtin_amdgcn_perm(ud, uc, 0x0c0c0400u);
    return __builtin_amdgcn_perm(cd, ab, 0x05040100u);
}

namespace pg8 {
constexpr int BM = 256, BK = 64, HALF = 128, HTB = HALF * BK * 2, STAGE_BYTES = 8 * HTB, NXCD = 8, WGM = 8;
__host__ __device__ __forceinline__ int lds_byte(int r, int c) { const int st = (r >> 4) * 2 + (c >> 5), rr = r & 15, cc = c & 31, ob = rr * 64 + cc * 2; return st * 1024 + (ob ^ (((ob >> 9) & 1) << 5)); }
__host__ __device__ __forceinline__ void stage_rc(int b, int& R, int& C) { const int st = b / 1024, sb = b % 1024, swz = sb ^ (((sb >> 9) & 1) << 5); R = (st >> 1) * 16 + swz / 64; C = (st & 1) * 32 + (swz % 64) / 2; }
__host__ __device__ __forceinline__ int perm32(int rho) { const int n = rho >> 4, i = rho & 15; return 8 * (i >> 2) + 4 * n + (i & 3); }

typedef int v8i_t __attribute__((ext_vector_type(8)));
typedef int v4i_t __attribute__((ext_vector_type(4)));
__device__ __forceinline__ v8i_t cat8(const bf16x8& lo, const bf16x8& hi) { typedef int v4i_t __attribute__((ext_vector_type(4))); const v4i_t a = __builtin_bit_cast(v4i_t, lo), b = __builtin_bit_cast(v4i_t, hi); return (v8i_t){a[0], a[1], a[2], a[3], b[0], b[1], b[2], b[3]}; }
struct Unit { int pm, pn; };
struct TileOrder {
    int nM, nN, nwg, G, c;
    __device__ __forceinline__ void init(int nM_, int nN_, int G_, int c_) { nM = nM_; nN = nN_; nwg = nM * nN; G = G_; c = c_; }
    __device__ __forceinline__ bool next(int i, Unit& u) const {
        const long L = (long)i * G + c; if (L >= nwg) return false;
        int wgid = (int)L; { const int q = nwg / NXCD, r = nwg % NXCD, xcd = wgid % NXCD, off = wgid / NXCD; wgid = (xcd < r ? xcd * (q + 1) : r * (q + 1) + (xcd - r) * q) + off; }
        const int nig = WGM * nN, gid = wgid / nig, fm = gid * WGM, gsz = (nM - fm) < WGM ? (nM - fm) : WGM;
        u.pm = fm + ((wgid % nig) % gsz); u.pn = (wgid % nig) / gsz; return true;
    }
};

template <class Epi, class Prob, bool ALIGN_EPI>
__device__ __forceinline__ void gemm_phase(LAS unsigned char* lds, const Prob& S, const Epi& E) {
    int tid = threadIdx.x; asm volatile("" : "+v"(tid));
    const int wid = __builtin_amdgcn_readfirstlane(tid >> 6), lane = tid & 63, wr = wid >> 2, wc = wid & 3, fr = lane & 15, fq = lane >> 4;
    const int lda = S.lda, ldb = S.ldb; int nt = 0;
    int Rr[2], Cc[2]; unsigned voffB[2];
#pragma unroll
    for (int i = 0; i < 2; ++i) { stage_rc(tid * 16 + i * 8192, Rr[i], Cc[i]); const int Rb = Epi::PERM ? ((Rr[i] & ~31) + perm32(Rr[i] & 31)) : Rr[i];
        voffB[i] = (unsigned)(Rb * ldb + Cc[i]) * 2u; }
    const size_t kstep = (size_t)(BK * 2);
    const size_t hstepA = (size_t)HALF * lda * 2, hstepB = (size_t)HALF * ldb * 2;
    const unsigned ldsw = (unsigned)wid * 1024u;
    const int aoff = lds_byte(wr * 64 + fr, fq * 8), boff = lds_byte(wc * 32 + fr, fq * 8);
#define PG8_SA(b, h) (((b) * 2 + (h)) * HTB)
#define PG8_SB(b, h) ((4 + (b) * 2 + (h)) * HTB)
#define PG8_STAGE(bufoff, gbase, voff) do { _Pragma("unroll") for (int _i = 0; _i < 2; ++_i) \
        __builtin_amdgcn_global_load_lds((const unsigned*)((const char*)(gbase) + (voff)[_i]), (LAS unsigned*)(lds + (bufoff) + ldsw + _i * 8192), 16, 0, 0); } while (0)
#define PG8_STAGE_A(bufoff, ptr, h, VO) do { if constexpr (Prob::GATHER) { PG8_STAGE(bufoff, ptr, VO[h]); } else { PG8_STAGE(bufoff, (ptr) + (h) * hstepA, VO[0]); } } while (0)
#define PG8_STAGE_B(bufoff, ptr, h) PG8_STAGE(bufoff, (ptr) + (h) * hstepB, voffB)
#define PG8_LDA(dst, b, h) do { _Pragma("unroll") for (int m = 0; m < 4; ++m) { if constexpr (Prob::FP8) { dst##8[m].lo = *(const LAS v4i_t*)(lds + PG8_SA(b, h) + aoff + m * 2048); dst##8[m].hi = *(const LAS v4i_t*)(lds + PG8_SA(b, h) + aoff + m * 2048 + 1024); } \
        else { _Pragma("unroll") for (int k = 0; k < 2; ++k) dst[m][k] = *(const LAS bf16x8*)(lds + PG8_SA(b, h) + aoff + m * 2048 + k * 1024); } } } while (0)
#define PG8_LDB(dst, b, h) do { _Pragma("unroll") for (int n = 0; n < 2; ++n) { if constexpr (Prob::FP8) { dst##8[n].lo = *(const LAS v4i_t*)(lds + PG8_SB(b, h) + boff + n * 2048); dst##8[n].hi = *(const LAS v4i_t*)(lds + PG8_SB(b, h) + boff + n * 2048 + 1024); } \
        else { _Pragma("unroll") for (int k = 0; k < 2; ++k) dst[n][k] = *(const LAS bf16x8*)(lds + PG8_SB(b, h) + boff + n * 2048 + k * 1024); } } } while (0)
#define PG8_MMA(ai, bj, At, Bt) do { __builtin_amdgcn_s_setprio(1); _Pragma("unroll") for (int m = 0; m < 4; ++m) _Pragma("unroll") for (int n = 0; n < 2; ++n) { \
        if constexpr (Prob::FP8) { asm volatile("v_mfma_scale_f32_16x16x128_f8f6f4 %0, %1, %2, %0, %3, %4 op_sel_hi:[0,0,0]" : "+v"(acc[ai][bj][m][n]) : "v"(Bt##8[n]), "v"(At##8[m]), "v"(sclB), "v"(sclA)); } \
        else if constexpr (Prob::I8) { _Pragma("unroll") for (int k = 0; k < 2; ++k) acc[ai][bj][m][n] = __builtin_bit_cast(f32x4, __builtin_amdgcn_mfma_i32_16x16x64_i8(__builtin_bit_cast(v4i_t, Bt[n][k]), __builtin_bit_cast(v4i_t, At[m][k]), __builtin_bit_cast(v4i_t, acc[ai][bj][m][n]), 0, 0, 0)); } \
        else { _Pragma("unroll") for (int k = 0; k < 2; ++k) acc[ai][bj][m][n] = __builtin_amdgcn_mfma_f32_16x16x32_bf16(Bt[n][k], At[m][k], acc[ai][bj][m][n], 0, 0, 0); } } __builtin_amdgcn_s_setprio(0); } while (0)
#define PG8_WAIT_V(n) asm volatile("s_waitcnt vmcnt(" #n ")" ::: "memory")
#define PG8_WAIT_L(n) asm volatile("s_waitcnt lgkmcnt(" #n ")" ::: "memory")
#define PG8_BAR __builtin_amdgcn_s_barrier()
#define PG8_SCHED __builtin_amdgcn_sched_barrier(0)
#define PG8_SETOFFS(VO, u) do { _Pragma("unroll") for (int _h = 0; _h < 2; ++_h) _Pragma("unroll") for (int _i = 0; _i < 2; ++_i) { \
        if constexpr (Prob::GATHER) VO[_h][_i] = (unsigned)(S.a_row(u, _h, Rr[_i]) * lda + Cc[_i]) * 2u; else VO[_h][_i] = (unsigned)(Rr[_i] * lda + Cc[_i]) * 2u; } } while (0)
    Unit cur, nxt; int ui = 0;
    if (!S.next(0, cur)) return;
    nt = S.nt_of(cur);
    f32x4 acc[2][2][4][2];
#pragma unroll
    for (int a = 0; a < 2; ++a)
#pragma unroll
        for (int b = 0; b < 2; ++b)
#pragma unroll
            for (int m = 0; m < 4; ++m)
#pragma unroll
                for (int n = 0; n < 2; ++n) acc[a][b][m][n] = (f32x4){0.f, 0.f, 0.f, 0.f};
    bf16x8 At[4][2], B0[2][2], B1[2][2];
    v8i_t At8[4], B08[2], B18[2];
    int sclA = Prob::SCALE_A, sclB = Prob::SCALE_B; asm volatile("" : "+v"(sclA), "+v"(sclB));
    unsigned voA[2][2], voN[2][2];
    PG8_SETOFFS(voA, cur);
    const char* cA = S.a_base(cur); const char* cB = S.b_base(cur);
    if constexpr (Prob::STAGGER > 0) {
        if ((int)blockIdx.x & 1) { for (int s_ = 0; s_ < Prob::STAGGER; ++s_) __builtin_amdgcn_s_sleep(127); } }
    PG8_STAGE_B(PG8_SB(0, 0), cB, 0); PG8_STAGE_B(PG8_SB(0, 1), cB, 1); PG8_STAGE_A(PG8_SA(0, 0), cA, 0, voA); PG8_STAGE_A(PG8_SA(0, 1), cA, 1, voA);
    if (wr == 1) PG8_BAR;
    PG8_WAIT_V(2); PG8_BAR;
    PG8_STAGE_B(PG8_SB(1, 0), cB + kstep, 0); PG8_STAGE_A(PG8_SA(1, 0), cA + kstep, 0, voA); PG8_STAGE_B(PG8_SB(1, 1), cB + kstep, 1);
    PG8_WAIT_V(6); PG8_BAR;
    for (;;) {
        const bool has_next = S.next(ui + 1, nxt);
        const char* nA = cA; const char* nB = cB;
        if (has_next) { nA = S.a_base(nxt); nB = S.b_base(nxt); }
        if constexpr (Prob::GATHER) {
            if (has_next) { PG8_SETOFFS(voN, nxt); }
            else {
#pragma unroll
                for (int h = 0; h < 2; ++h)
#pragma unroll
                    for (int i = 0; i < 2; ++i) voN[h][i] = voA[h][i]; }
        }
        for (int t = 0; t < nt; t += 2) {
            const bool last = (t == nt - 2);
            const char* a1 = cA + (size_t)(t + 1) * kstep;
            const char* a2 = last ? nA : cA + (size_t)(t + 2) * kstep; const char* b2 = last ? nB : cB + (size_t)(t + 2) * kstep;
            const char* a3 = a2 + kstep; const char* b3 = b2 + kstep;
            unsigned v2[2][2];
#pragma unroll
            for (int h = 0; h < 2; ++h)
#pragma unroll
                for (int i = 0; i < 2; ++i) { if constexpr (Prob::GATHER) v2[h][i] = last ? voN[h][i] : voA[h][i]; else v2[h][i] = voA[h][i]; }
            PG8_LDB(B0, 0, 0); PG8_LDB(B1, 0, 1); PG8_SCHED; PG8_LDA(At, 0, 0); PG8_STAGE_A(PG8_SA(1, 1), a1, 1, voA);
            PG8_WAIT_V(8); PG8_WAIT_L(0); PG8_BAR; PG8_MMA(0, 0, At, B0); PG8_MMA(0, 1, At, B1); PG8_BAR; PG8_SCHED;
            PG8_LDA(At, 0, 1); PG8_STAGE_B(PG8_SB(0, 0), b2, 0); PG8_STAGE_B(PG8_SB(0, 1), b2, 1); PG8_STAGE_A(PG8_SA(0, 0), a2, 0, v2);
            PG8_WAIT_V(8); PG8_WAIT_L(0); PG8_BAR; PG8_MMA(1, 0, At, B0); PG8_MMA(1, 1, At, B1); PG8_BAR; PG8_SCHED;
            PG8_LDB(B0, 1, 0); PG8_LDB(B1, 1, 1); PG8_SCHED; PG8_LDA(At, 1, 0); PG8_STAGE_A(PG8_SA(0, 1), a2, 1, v2);
            PG8_WAIT_V(8); PG8_WAIT_L(0); PG8_BAR; PG8_MMA(0, 0, At, B0); PG8_MMA(0, 1, At, B1); PG8_BAR; PG8_SCHED;
            PG8_LDA(At, 1, 1); PG8_STAGE_B(PG8_SB(1, 0), b3, 0); PG8_STAGE_B(PG8_SB(1, 1), b3, 1); PG8_STAGE_A(PG8_SA(1, 0), a3, 0, v2);
            PG8_WAIT_V(8); PG8_WAIT_L(0); PG8_BAR; PG8_MMA(1, 0, At, B0); PG8_MMA(1, 1, At, B1); PG8_BAR; PG8_SCHED;
        }
        if constexpr (ALIGN_EPI) { if (wr == 0) PG8_BAR; }
        if constexpr (Prob::FP8) asm volatile("s_nop 15\n\ts_nop 15" ::: "memory");
        { int fr_ = fr, fq_ = fq; asm volatile("" : "+v"(fr_), "+v"(fq_));
          if constexpr (Epi::TWO_SEG) { if (S.is_mid(cur)) E.mid(acc, cur, wr, wc, fr_, fq_); else E(acc, cur, wr, wc, fr_, fq_); }
          else E(acc, cur, wr, wc, fr_, fq_);
        }
        if (!has_next) break;
        bool zero_acc = true; if constexpr (Epi::TWO_SEG) zero_acc = !S.is_mid(cur);
        if (zero_acc) {
#pragma unroll
        for (int a = 0; a < 2; ++a)
#pragma unroll
            for (int b = 0; b < 2; ++b)
#pragma unroll
                for (int m = 0; m < 4; ++m)
#pragma unroll
                    for (int n = 0; n < 2; ++n) acc[a][b][m][n] = (f32x4){0.f, 0.f, 0.f, 0.f};
        }
        cur = nxt; cA = nA; cB = nB; ++ui; nt = S.nt_of(cur);
        if constexpr (Prob::GATHER) {
#pragma unroll
            for (int h = 0; h < 2; ++h)
#pragma unroll
                for (int i = 0; i < 2; ++i) voA[h][i] = voN[h][i]; }
        if constexpr (ALIGN_EPI) { if (wr == 1) PG8_BAR; }
    }
    PG8_WAIT_V(0);
    if constexpr (!ALIGN_EPI) { if (wr == 0) PG8_BAR; }
    PG8_BAR;
#undef PG8_SA
#undef PG8_SB
#undef PG8_STAGE
#undef PG8_STAGE_A
#undef PG8_STAGE_B
#undef PG8_LDA
#undef PG8_LDB
#undef PG8_MMA
#undef PG8_WAIT_V
#undef PG8_WAIT_L
#undef PG8_BAR
#undef PG8_SCHED
#undef PG8_SETOFFS
}
}

constexpr size_t MiB = 1u << 20;
constexpr size_t WS_CTL = 0, CTL_ZERO_BYTES = 1 * MiB;
constexpr size_t WS_ADA = 1 * MiB;
constexpr size_t WS_FL2 = 2 * MiB;
constexpr size_t WS_LOGF = 3 * MiB;
constexpr size_t WS_TOKE = 4 * MiB;
constexpr size_t WS_TOKW = 4 * MiB + 256 * 1024;
constexpr size_t WS_SORT = 5 * MiB;
constexpr size_t WS_A32 = 6 * MiB;
constexpr size_t WS_AU = 8 * MiB;
constexpr size_t WS_Y2 = 8 * MiB;
constexpr size_t WS_SLOC = 48 * MiB;
constexpr size_t WS_WIN = 64 * MiB;
constexpr size_t WS_WPA = 80 * MiB;
constexpr size_t WS_WPS = 82 * MiB;
constexpr size_t WS_WOUT = 84 * MiB;
constexpr size_t WS_WGLU = 88 * MiB;
constexpr size_t WS_TG = 89 * MiB;
constexpr size_t WS_WST = 129 * MiB;
constexpr size_t WS_WUPD = 145 * MiB;
constexpr size_t WS_WDND = 156 * MiB;
constexpr size_t WS_H = 162 * MiB;
constexpr size_t WS_Q = 226 * MiB;
constexpr size_t WS_K = 258 * MiB;
constexpr size_t WS_V = 290 * MiB;
constexpr size_t WS_MIX = 258 * MiB;
constexpr size_t WS_GATES = 322 * MiB;
constexpr size_t WS_Y = 450 * MiB;
constexpr size_t WS_HID = 226 * MiB;
constexpr size_t WS_WUPM = 64 * MiB;
constexpr size_t WS_WDNM = 484 * MiB;
constexpr size_t WS_END = 506 * MiB;
constexpr size_t WS_SL = WS_AU;
constexpr int SLAB_ROWS = 14 * 256;
constexpr size_t WS_LS = WS_LOGF;
constexpr size_t WS_TMPX = WS_Q;
constexpr size_t WS_KTAB = 482 * MiB;
constexpr size_t WS_XB = WS_H;
constexpr size_t WS_H8 = WS_Y;
static_assert(WS_XB + (size_t)TOK * DMODEL * 2 <= WS_Q && WS_WDNM + (size_t)8 * 1024 * DFF <= WS_END && (size_t)8 * 5632 * 1024 <= (size_t)TOK * DMODEL * 4, "residual stream / fp8 MoE weights");
constexpr size_t WS_SA1 = 6 * MiB + 128 * 1024, WS_SA2 = 6 * MiB + 256 * 1024;
constexpr int CW_CMAX = 65536;
static_assert(WS_K - WS_Q == (size_t)TOK * 512 * 2 && WS_V - WS_K == (size_t)TOK * 512 * 2, "q|k|v contiguous");
static_assert(WS_HID + (size_t)TOK * DFF * 2 <= WS_Y && WS_HID + (size_t)(128 + 142) * 256 * DFF <= WS_Y, "hidden buffers (dense bf16 / MoE fp8: chunk 0, then chunk 1 + leftover) end below Y");
constexpr int SLOT_CAP = 34816;
constexpr size_t SORT_ROWLIST = 0, SORT_SLOTW = 2 * SLOT_CAP * 4, SORT_PEXP = 4 * SLOT_CAP * 4, SORT_NP = SORT_PEXP + 2 * 136 * 4, SORT_CNT = SORT_NP + 64;
constexpr size_t SORT_PANEL = SORT_CNT + 256 * 16 * 4, SORT_NPC = SORT_PANEL + 3 * 136 * 4;
constexpr size_t SORT_PANELM = SORT_NPC + 64, SORT_NPM = SORT_PANELM + 144 * 4;
static_assert(SORT_NPM + 64 <= MiB, "sort tables");
constexpr int CW_BAR = 4096;

namespace pg8 {
struct ProbPlain {
    static constexpr bool FP8 = false; static constexpr int SCALE_A = 0, SCALE_B = 0;
    static constexpr bool GATHER = false; static constexpr int STAGGER = 0; static constexpr bool I8 = false;
    const bf16_t* A; const bf16_t* Bt; int K, lda, ldb; TileOrder ord;
    __device__ __forceinline__ bool next(int i, Unit& u) const { return ord.next(i, u); }
    __device__ __forceinline__ const char* a_base(const Unit& u) const { return (const char*)A + (size_t)u.pm * 256 * lda * 2; }
    __device__ __forceinline__ const char* b_base(const Unit& u) const { return (const char*)Bt + (size_t)u.pn * 256 * ldb * 2; }
    __device__ __forceinline__ int a_row(const Unit&, int, int) const { return 0; }
    __device__ __forceinline__ int nt_of(const Unit&) const { return K / BK; }
};
struct ProbPlain8 {
    static constexpr bool GATHER = false, FP8 = true; static constexpr int STAGGER = 0; static constexpr bool I8 = false; static constexpr int SCALE_A = 0x7F7F7F7F, SCALE_B = 0x79797979;
    const bf16_t* A; const bf16_t* Bt; int K, lda, ldb; TileOrder ord;
    __device__ __forceinline__ bool next(int i, Unit& u) const { return ord.next(i, u); }
    __device__ __forceinline__ const char* a_base(const Unit& u) const { return (const char*)A + (size_t)u.pm * 256 * lda * 2; }
    __device__ __forceinline__ const char* b_base(const Unit& u) const { return (const char*)Bt + (size_t)u.pn * 256 * ldb * 2; }
    __device__ __forceinline__ int a_row(const Unit&, int, int) const { return 0; }
    __device__ __forceinline__ int nt_of(const Unit&) const { return K / BK; }
};
struct ProbProj2 {
    static constexpr bool GATHER = false, FP8 = false; static constexpr int STAGGER = 0; static constexpr bool I8 = false; static constexpr int SCALE_A = 0, SCALE_B = 0;
    const bf16_t* A0; long dA; const bf16_t* B0; long dB; int K, lda, ldb; TileOrder ord;
    __device__ __forceinline__ bool next(int i, Unit& u) const { Unit t; if (!ord.next(i >> 1, t)) return false; u.pm = t.pm; u.pn = 2 * t.pn + (i & 1); return true; }
    __device__ __forceinline__ bool is_mid(const Unit& u) const { return (u.pn & 1) == 0; }
    __device__ __forceinline__ const char* a_base(const Unit& u) const { return (const char*)A0 + (long)(u.pn & 1) * dA + (size_t)u.pm * 256 * lda * 2; }
    __device__ __forceinline__ const char* b_base(const Unit& u) const { return (const char*)B0 + (long)(u.pn & 1) * dB + (size_t)(u.pn >> 1) * 256 * ldb * 2; }
    __device__ __forceinline__ int a_row(const Unit&, int, int) const { return 0; }
    __device__ __forceinline__ int nt_of(const Unit&) const { return K / BK; }
};
struct ProbPlainI8 {
    static constexpr bool GATHER = false, FP8 = false, I8 = true; static constexpr int STAGGER = 0, SCALE_A = 0, SCALE_B = 0;
    const bf16_t* A; const bf16_t* Bt; int K, lda, ldb; TileOrder ord;
    __device__ __forceinline__ bool next(int i, Unit& u) const { return ord.next(i, u); }
    __device__ __forceinline__ const char* a_base(const Unit& u) const { return (const char*)A + (size_t)u.pm * 256 * lda * 2; }
    __device__ __forceinline__ const char* b_base(const Unit& u) const { return (const char*)Bt + (size_t)u.pn * 256 * ldb * 2; }
    __device__ __forceinline__ int a_row(const Unit&, int, int) const { return 0; }
    __device__ __forceinline__ int nt_of(const Unit&) const { return K / BK; }
};
struct ProbUpI8 {
    static constexpr bool GATHER = true, FP8 = false, I8 = true; static constexpr int STAGGER = 0, SCALE_A = 0, SCALE_B = 0;
    const bf16_t* A; const bf16_t* Bt; const int* rowlist; const int* pexp; const int* panel; int K, lda, ldb; TileOrder ord;
    __device__ __forceinline__ bool next(int i, Unit& u) const { return ord.next(i, u); }
    __device__ __forceinline__ int desc(const Unit& u) const { return __builtin_amdgcn_readfirstlane(__hip_atomic_load(panel + u.pm, RLX_AGENT)); }
    __device__ __forceinline__ const char* a_base(const Unit&) const { return (const char*)A; }
    __device__ __forceinline__ const char* b_base(const Unit& u) const { return (const char*)Bt + (size_t)u.pn * 256 * ldb * 2; }
    __device__ __forceinline__ int a_row(const Unit& u, int h, int R) const { const int d = desc(u); const int r = __hip_atomic_load(rowlist + (d / 136) * SLOT_CAP + (d % 136) * 256 + h * 128 + R, RLX_AGENT); return r < 0 ? 0 : r; }
    __device__ __forceinline__ int nt_of(const Unit&) const { return K / BK; }
};
struct ProbS5b {
    static constexpr bool FP8 = false; static constexpr int SCALE_A = 0, SCALE_B = 0;
    static constexpr bool GATHER = false; static constexpr int STAGGER = 0; static constexpr bool I8 = false;
    const bf16_t* A; const bf16_t* Bt; int K, lda, ldb; TileOrder ord;
    __device__ __forceinline__ bool next(int i, Unit& u) const { return ord.next(i, u); }
    __device__ __forceinline__ const char* a_base(const Unit& u) const { return (const char*)A + (size_t)u.pm * 256 * lda * 2; }
    __device__ __forceinline__ const char* b_base(const Unit& u) const { return (const char*)Bt + (size_t)(u.pm >> 2) * 256 * ldb * 2; }
    __device__ __forceinline__ int a_row(const Unit&, int, int) const { return 0; }
    __device__ __forceinline__ int nt_of(const Unit&) const { return K / BK; }
};
struct ProbS5ad {
    static constexpr bool FP8 = false; static constexpr int SCALE_A = 0, SCALE_B = 0;
    static constexpr bool GATHER = false; static constexpr int STAGGER = 0; static constexpr bool I8 = false;
    const bf16_t* A; const bf16_t* Bt; int K, lda, ldb; TileOrder ord;
    __device__ __forceinline__ bool next(int i, Unit& u) const { return ord.next(i, u); }
    __device__ __forceinline__ const char* a_base(const Unit& u) const { return (const char*)A + (size_t)u.pm * 256 * lda * 2; }
    __device__ __forceinline__ const char* b_base(const Unit& u) const { return (const char*)Bt + ((size_t)(u.pm >> 2) * 512 + (size_t)u.pn * 256) * ldb * 2; }
    __device__ __forceinline__ int a_row(const Unit&, int, int) const { return 0; }
    __device__ __forceinline__ int nt_of(const Unit&) const { return K / BK; }
};
struct ProbUp {
    static constexpr bool FP8 = false; static constexpr int SCALE_A = 0, SCALE_B = 0;
    static constexpr bool GATHER = true; static constexpr int STAGGER = 0; static constexpr bool I8 = false;
    const bf16_t* A; const bf16_t* Bt; const int* rowlist; const int* pexp; const int* panel; int K, lda, ldb; TileOrder ord;
    __device__ __forceinline__ bool next(int i, Unit& u) const { return ord.next(i, u); }
    __device__ __forceinline__ int desc(const Unit& u) const { return __builtin_amdgcn_readfirstlane(__hip_atomic_load(panel + u.pm, RLX_AGENT)); }
    __device__ __forceinline__ const char* a_base(const Unit&) const { return (const char*)A; }
    __device__ __forceinline__ const char* b_base(const Unit& u) const { const int e = __builtin_amdgcn_readfirstlane(__hip_atomic_load(pexp + desc(u), RLX_AGENT));
        return (const char*)Bt + ((size_t)e * 5632 + (size_t)u.pn * 256) * ldb * 2; }
    __device__ __forceinline__ int a_row(const Unit& u, int h, int R) const { const int d = desc(u); const int r = __hip_atomic_load(rowlist + (d / 136) * SLOT_CAP + (d % 136) * 256 + h * 128 + R, RLX_AGENT); return r < 0 ? 0 : r; }
    __device__ __forceinline__ int nt_of(const Unit&) const { return K / BK; }
};
struct ProbUp8 {
    static constexpr bool GATHER = true, FP8 = true; static constexpr int STAGGER = 0; static constexpr bool I8 = false; static constexpr int SCALE_A = 0x7F7F7F7F, SCALE_B = 0x79797979;
    const bf16_t* A; const bf16_t* Bt; const int* rowlist; const int* pexp; const int* panel; int K, lda, ldb; TileOrder ord;
    __device__ __forceinline__ bool next(int i, Unit& u) const { return ord.next(i, u); }
    __device__ __forceinline__ int desc(const Unit& u) const { return __builtin_amdgcn_readfirstlane(__hip_atomic_load(panel + u.pm, RLX_AGENT)); }
    __device__ __forceinline__ const char* a_base(const Unit&) const { return (const char*)A; }
    __device__ __forceinline__ const char* b_base(const Unit& u) const { const int e = __builtin_amdgcn_readfirstlane(__hip_atomic_load(pexp + desc(u), RLX_AGENT));
        return (const char*)Bt + ((size_t)e * 5632 + (size_t)u.pn * 256) * ldb * 2; }
    __device__ __forceinline__ int a_row(const Unit& u, int h, int R) const { const int d = desc(u); const int r = __hip_atomic_load(rowlist + (d / 136) * SLOT_CAP + (d % 136) * 256 + h * 128 + R, RLX_AGENT); return r < 0 ? 0 : r; }
    __device__ __forceinline__ int nt_of(const Unit&) const { return K / BK; }
};
struct ProbDown8 {
    static constexpr bool GATHER = false, FP8 = true; static constexpr int STAGGER = 0; static constexpr bool I8 = false; static constexpr int SCALE_A = 0x7F7F7F7F, SCALE_B = 0x79797979;
    const bf16_t* A; const bf16_t* Bt; const int* pexp; const int* panel; int K, lda, ldb; TileOrder ord;
    __device__ __forceinline__ bool next(int i, Unit& u) const { return ord.next(i, u); }
    __device__ __forceinline__ const char* a_base(const Unit& u) const { return (const char*)A + (size_t)u.pm * 256 * lda * 2; }
    __device__ __forceinline__ const char* b_base(const Unit& u) const { const int d = __builtin_amdgcn_readfirstlane(__hip_atomic_load(panel + u.pm, RLX_AGENT));
        const int e = __builtin_amdgcn_readfirstlane(__hip_atomic_load(pexp + d, RLX_AGENT));
        return (const char*)Bt + ((size_t)e * 1024 + (size_t)u.pn * 256) * ldb * 2; }
    __device__ __forceinline__ int a_row(const Unit&, int, int) const { return 0; }
    __device__ __forceinline__ int nt_of(const Unit&) const { return K / BK; }
};
struct ProbDown8S {
    static constexpr bool GATHER = false, FP8 = true; static constexpr int STAGGER = 0; static constexpr bool I8 = false; static constexpr int SCALE_A = 0x7F7F7F7F, SCALE_B = 0x79797979;
    const bf16_t* A; const bf16_t* Bt; const int* pexp; const int* panel; int K, lda, ldb; TileOrder ord;
    __device__ __forceinline__ bool next(int i, Unit& u) const { return ord.next(i, u); }
    __device__ __forceinline__ const char* a_base(const Unit& u) const { return (const char*)A + (size_t)u.pm * 256 * lda * 2 + (size_t)(u.pn >> 2) * 8 * (BK * 2); }
    __device__ __forceinline__ const char* b_base(const Unit& u) const { const int d = __builtin_amdgcn_readfirstlane(__hip_atomic_load(panel + u.pm, RLX_AGENT));
        const int e = __builtin_amdgcn_readfirstlane(__hip_atomic_load(pexp + d, RLX_AGENT));
        return (const char*)Bt + ((size_t)e * 1024 + (size_t)(u.pn & 3) * 256) * ldb * 2 + (size_t)(u.pn >> 2) * 8 * (BK * 2); }
    __device__ __forceinline__ int a_row(const Unit&, int, int) const { return 0; }
    __device__ __forceinline__ int nt_of(const Unit& u) const { return (u.pn >> 2) < 2 ? 8 : K / BK - 16; }
};
struct ProbDown {
    static constexpr bool FP8 = false; static constexpr int SCALE_A = 0, SCALE_B = 0;
    static constexpr bool GATHER = false; static constexpr int STAGGER = 0; static constexpr bool I8 = false;
    const bf16_t* A; const bf16_t* Bt; const int* pexp; const int* panel; int K, lda, ldb; TileOrder ord;
    __device__ __forceinline__ bool next(int i, Unit& u) const { return ord.next(i, u); }
    __device__ __forceinline__ const char* a_base(const Unit& u) const { return (const char*)A + ((size_t)u.pm * 256 * lda + (size_t)(u.pn >> 2) * K) * 2; }
    __device__ __forceinline__ const char* b_base(const Unit& u) const { const int d = __builtin_amdgcn_readfirstlane(__hip_atomic_load(panel + u.pm, RLX_AGENT));
        const int e = __builtin_amdgcn_readfirstlane(__hip_atomic_load(pexp + d, RLX_AGENT));
        return (const char*)Bt + (((size_t)e * 1024 + (size_t)(u.pn & 3) * 256) * ldb + (size_t)(u.pn >> 2) * K) * 2; }
    __device__ __forceinline__ int a_row(const Unit&, int, int) const { return 0; }
    __device__ __forceinline__ int nt_of(const Unit&) const { return K / BK; }
};

typedef f32x4 AccT[2][2][4][2];
__device__ __forceinline__ f32x4 i2f_4(const f32x4& a) { return (f32x4){(float)__float_as_int(a[0]), (float)__float_as_int(a[1]), (float)__float_as_int(a[2]), (float)__float_as_int(a[3])}; }
__device__ __forceinline__ u32x4 pack8(const f32x4& v0, const f32x4& v1) { u32x4 w; w.x = cvt_pk_bf16(v0[0], v0[1]); w.y = cvt_pk_bf16(v0[2], v0[3]); w.z = cvt_pk_bf16(v1[0], v1[1]); w.w = cvt_pk_bf16(v1[2], v1[3]); return w; }
__device__ __forceinline__ void unpack8(const u32x4& w, f32x4& v0, f32x4& v1) { v0 = (f32x4){bf_lo(w.x), bf_hi(w.x), bf_lo(w.y), bf_hi(w.y)}; v1 = (f32x4){bf_lo(w.z), bf_hi(w.z), bf_lo(w.w), bf_hi(w.w)}; }

template <bool I8> struct EpiIn {
    static constexpr bool PERM = true; static constexpr bool TWO_SEG = false;
    bf16_t* QKV; bf16_t* AU; bf16_t* Gates; const float* bgate; int pn_off; const float* sa; const unsigned* cmax;
    __device__ __forceinline__ void operator()(const AccT& acc, const Unit& u, int wr, int wc, int fr, int fq) const {
        const int pn = u.pn + pn_off, row0 = u.pm * BM + wr * 64 + fr, colw = wc * 32 + 8 * fq;
        float sar[2][4]; f32x4 sbv[2][2];
        if (I8) {
#pragma unroll
            for (int ai = 0; ai < 2; ++ai)
#pragma unroll
                for (int m = 0; m < 4; ++m) sar[ai][m] = sa[row0 + ai * HALF + m * 16] * (1.0f / 127.0f);
#pragma unroll
            for (int bj = 0; bj < 2; ++bj)
#pragma unroll
                for (int n = 0; n < 2; ++n) { const u32x4 cb = *(const u32x4*)(cmax + u.pn * 256 + bj * HALF + colw + 4 * n); sbv[bj][n] = (f32x4){__uint_as_float(cb.x), __uint_as_float(cb.y), __uint_as_float(cb.z), __uint_as_float(cb.w)}; }
        }
#define EPI_V(ai, bj, m, n) (I8 ? i2f_4(acc[ai][bj][m][n]) * (sbv[bj][n] * sar[ai][m]) : acc[ai][bj][m][n])
        if (pn < 6) {
            bf16_t* base = QKV + (size_t)(pn >> 1) * ((size_t)TOK * 512); const float sc = pn < 2 ? C2Q : 1.0f; const int c0 = (pn & 1) * 256 + colw;
#pragma unroll
            for (int ai = 0; ai < 2; ++ai)
#pragma unroll
                for (int m = 0; m < 4; ++m) { bf16_t* rowp = base + (size_t)(row0 + ai * HALF + m * 16) * 512 + c0;
#pragma unroll
                    for (int bj = 0; bj < 2; ++bj) { *(u32x4*)(rowp + bj * HALF) = pack8(EPI_V(ai, bj, m, 0) * sc, EPI_V(ai, bj, m, 1) * sc); } }
        } else if (pn < 8) {
#pragma unroll
            for (int ai = 0; ai < 2; ++ai)
#pragma unroll
                for (int m = 0; m < 4; ++m) { const int row = row0 + ai * HALF + m * 16, b = row >> 11, t = row & 2047, chunk = t >> 5, s = t & 31;
#pragma unroll
                    for (int bj = 0; bj < 2; ++bj) { const int cu = (pn - 6) * 256 + bj * HALF + colw, g = cu >> 4, hh = cu & 15;
                        *(u32x4*)(AU + ((size_t)(g * 1024 + b * 64 + chunk) * 640 + s * 16 + hh)) = pack8(EPI_V(ai, bj, m, 0), EPI_V(ai, bj, m, 1)); } }
        } else {
            const int c0 = (pn - 8) * 256 + colw;
            f32x4 bv[2][2];
#pragma unroll
            for (int bj = 0; bj < 2; ++bj)
#pragma unroll
                for (int n = 0; n < 2; ++n) bv[bj][n] = *(const f32x4*)(bgate + c0 + bj * HALF + 4 * n);
#pragma unroll
            for (int ai = 0; ai < 2; ++ai)
#pragma unroll
                for (int m = 0; m < 4; ++m) { bf16_t* rowp = Gates + (size_t)(row0 + ai * HALF + m * 16) * 2048 + c0;
#pragma unroll
                    for (int bj = 0; bj < 2; ++bj) { const f32x4 v0 = EPI_V(ai, bj, m, 0) + bv[bj][0], v1 = EPI_V(ai, bj, m, 1) + bv[bj][1];
                        *(u32x4*)(rowp + bj * HALF) = pack8(sigmoid_4(v0), sigmoid_4(v1)); } }
        }
#undef EPI_V
    }
};
struct EpiS5b {
    static constexpr bool PERM = false; static constexpr bool TWO_SEG = false;
    float* Sloc;
    __device__ __forceinline__ void operator()(const AccT& acc, const Unit& u, int wr, int wc, int fr, int fq) const {
        const int row0 = u.pm * BM + wr * 64 + fr;
#pragma unroll
        for (int ai = 0; ai < 2; ++ai)
#pragma unroll
            for (int m = 0; m < 4; ++m) { float* rowp = Sloc + (size_t)(row0 + ai * HALF + m * 16) * 128 + wc * 32 + 4 * fq;
#pragma unroll
                for (int n = 0; n < 2; ++n) *(f32x4*)(rowp + 16 * n) = acc[ai][0][m][n]; }
    }
};
struct EpiS5ad {
    static constexpr bool PERM = true; static constexpr bool TWO_SEG = false;
    const bf16_t* AU; bf16_t* Y; const float* dskip;
    __device__ __forceinline__ void operator()(const AccT& acc, const Unit& u, int wr, int wc, int fr, int fq) const {
        const int g = u.pm >> 2, rg0 = (u.pm & 3) * BM + wr * 64 + fr, ho = 8 * (fq & 1);
        const f32x4 d0 = *(const f32x4*)(dskip + g * 16 + ho), d1 = *(const f32x4*)(dskip + g * 16 + ho + 4);
        u32x4 uw[2][4][2];
#pragma unroll
        for (int ai = 0; ai < 2; ++ai)
#pragma unroll
            for (int m = 0; m < 4; ++m)
#pragma unroll
                for (int bj = 0; bj < 2; ++bj) { const int r = rg0 + ai * HALF + m * 16, c = u.pn * 256 + bj * HALF + wc * 32 + 8 * fq; uw[ai][m][bj] = *(const u32x4*)(AU + ((size_t)(g * 1024 + r) * 640 + c)); }
#pragma unroll
        for (int ai = 0; ai < 2; ++ai)
#pragma unroll
            for (int m = 0; m < 4; ++m) { const int r = rg0 + ai * HALF + m * 16, b = r >> 6, chunk = r & 63;
#pragma unroll
                for (int bj = 0; bj < 2; ++bj) { const int c = u.pn * 256 + bj * HALF + wc * 32 + 8 * fq, tl = c >> 4;
                    f32x4 u0, u1; unpack8(uw[ai][m][bj], u0, u1);
                    f32x4 v0 = acc[ai][bj][m][0] + d0 * u0, v1 = acc[ai][bj][m][1] + d1 * u1;
#pragma unroll
                    for (int j = 0; j < 4; ++j) { v0[j] = gelu_tanh(v0[j]); v1[j] = gelu_tanh(v1[j]); }
                    const int token = b * 2048 + chunk * 32 + tl;
                    *(u32x4*)(Y + (size_t)token * 512 + g * 16 + ho) = pack8(v0, v1); } }
    }
};
struct EpiGlu {
    static constexpr bool PERM = true; static constexpr bool TWO_SEG = false;
    const bf16_t* Y; bf16_t* Y2; const float* bglu;
    __device__ __forceinline__ void operator()(const AccT& acc, const Unit& u, int wr, int wc, int fr, int fq) const {
        const int row0 = u.pm * BM + wr * 64 + fr, c0 = u.pn * 256 + wc * 32 + 8 * fq;
        f32x4 bv[2][2];
#pragma unroll
        for (int bj = 0; bj < 2; ++bj)
#pragma unroll
            for (int n = 0; n < 2; ++n) bv[bj][n] = *(const f32x4*)(bglu + c0 + bj * HALF + 4 * n);
        u32x4 yw[2][4][2];
#pragma unroll
        for (int ai = 0; ai < 2; ++ai)
#pragma unroll
            for (int m = 0; m < 4; ++m)
#pragma unroll
                for (int bj = 0; bj < 2; ++bj) yw[ai][m][bj] = *(const u32x4*)(Y + (size_t)(row0 + ai * HALF + m * 16) * 512 + c0 + bj * HALF);
#pragma unroll
        for (int ai = 0; ai < 2; ++ai)
#pragma unroll
            for (int m = 0; m < 4; ++m) { const size_t ro = (size_t)(row0 + ai * HALF + m * 16) * 512 + c0;
#pragma unroll
                for (int bj = 0; bj < 2; ++bj) { f32x4 y0, y1; unpack8(yw[ai][m][bj], y0, y1);
                    f32x4 v0 = acc[ai][bj][m][0] + bv[bj][0], v1 = acc[ai][bj][m][1] + bv[bj][1];
#pragma unroll
                    for (int j = 0; j < 4; ++j) { v0[j] = y0[j] * fast_sigmoid(v0[j]); v1[j] = y1[j] * fast_sigmoid(v1[j]); }
                    *(u32x4*)(Y2 + ro + bj * HALF) = pack8(v0, v1); } }
    }
};
template <int MODE> struct EpiProj {
    static constexpr bool PERM = true; static constexpr bool TWO_SEG = false;
    const bf16_t* Gates; const bf16_t* Tin; bf16_t* Out;
    __device__ __forceinline__ void operator()(const AccT& acc, const Unit& u, int wr, int wc, int fr, int fq) const {
        const int row0 = u.pm * BM + wr * 64 + fr, c0 = u.pn * 256 + wc * 32 + 8 * fq;
#pragma unroll
        for (int ai = 0; ai < 2; ++ai) {
            u32x4 gw[4][2], tw[4][2];
#pragma unroll
            for (int m = 0; m < 4; ++m)
#pragma unroll
                for (int bj = 0; bj < 2; ++bj) { const size_t row = (size_t)(row0 + ai * HALF + m * 16); const int c = c0 + bj * HALF;
                    gw[m][bj] = *(const u32x4*)(Gates + row * 2048 + MODE * 1024 + c); if (MODE == 1) tw[m][bj] = *(const u32x4*)(Tin + row * 1024 + c); }
#pragma unroll
            for (int m = 0; m < 4; ++m) { const size_t row = (size_t)(row0 + ai * HALF + m * 16);
#pragma unroll
                for (int bj = 0; bj < 2; ++bj) { const int c = c0 + bj * HALF; f32x4 g0, g1; unpack8(gw[m][bj], g0, g1);
                    f32x4 v0 = acc[ai][bj][m][0] * g0, v1 = acc[ai][bj][m][1] * g1;
                    if (MODE == 1) { f32x4 t0, t1; unpack8(tw[m][bj], t0, t1); v0 += t0; v1 += t1; }
                    *(u32x4*)(Out + row * 1024 + c) = pack8(v0, v1); } }
        }
    }
};
struct EpiProj2 {
    static constexpr bool PERM = true, TWO_SEG = true;
    const bf16_t* Gates; bf16_t* Out;
    __device__ __forceinline__ void mid(AccT& acc, const Unit& u, int wr, int wc, int fr, int fq) const {
        const int row0 = u.pm * BM + wr * 64 + fr, c0 = (u.pn >> 1) * 256 + wc * 32 + 8 * fq;
#pragma unroll
        for (int ai = 0; ai < 2; ++ai) {
            u32x4 ga[4][2], gs[4][2];
#pragma unroll
            for (int m = 0; m < 4; ++m)
#pragma unroll
                for (int bj = 0; bj < 2; ++bj) { const size_t ro = (size_t)(row0 + ai * HALF + m * 16) * 2048 + c0 + bj * HALF; ga[m][bj] = *(const u32x4*)(Gates + ro); gs[m][bj] = *(const u32x4*)(Gates + ro + 1024); }
#pragma unroll
            for (int m = 0; m < 4; ++m)
#pragma unroll
                for (int bj = 0; bj < 2; ++bj) { f32x4 a0, a1, s0, s1; unpack8(ga[m][bj], a0, a1); unpack8(gs[m][bj], s0, s1);
#pragma unroll
                    for (int j = 0; j < 4; ++j) { acc[ai][bj][m][0][j] *= a0[j] * __builtin_amdgcn_rcpf(fmaxf(s0[j], 1e-30f)); acc[ai][bj][m][1][j] *= a1[j] * __builtin_amdgcn_rcpf(fmaxf(s1[j], 1e-30f)); } }
        }
    }
    __device__ __forceinline__ void operator()(const AccT& acc, const Unit& u, int wr, int wc, int fr, int fq) const {
        const int row0 = u.pm * BM + wr * 64 + fr, c0 = (u.pn >> 1) * 256 + wc * 32 + 8 * fq;
#pragma unroll
        for (int ai = 0; ai < 2; ++ai) {
            u32x4 gs[4][2];
#pragma unroll
            for (int m = 0; m < 4; ++m)
#pragma unroll
                for (int bj = 0; bj < 2; ++bj) gs[m][bj] = *(const u32x4*)(Gates + (size_t)(row0 + ai * HALF + m * 16) * 2048 + 1024 + c0 + bj * HALF);
#pragma unroll
            for (int m = 0; m < 4; ++m)
#pragma unroll
                for (int bj = 0; bj < 2; ++bj) { f32x4 s0, s1; unpack8(gs[m][bj], s0, s1);
                    *(u32x4*)(Out + (size_t)(row0 + ai * HALF + m * 16) * 1024 + c0 + bj * HALF) = pack8(acc[ai][bj][m][0] * s0, acc[ai][bj][m][1] * s1); }
        }
    }
};
template <bool IN_F32> struct EpiOut {
    static constexpr bool PERM = true; static constexpr bool TWO_SEG = false;
    const float* xin; bf16_t* xb; const float* gate; float mul;
    __device__ __forceinline__ void operator()(const AccT& acc, const Unit& u, int wr, int wc, int fr, int fq) const {
        const int row0 = u.pm * BM + wr * 64 + fr, c0 = u.pn * 256 + wc * 32 + 8 * fq; const int b = (u.pm * BM) >> 11;
        f32x4 gv[2][2];
#pragma unroll
        for (int bj = 0; bj < 2; ++bj)
#pragma unroll
            for (int n = 0; n < 2; ++n) gv[bj][n] = *(const f32x4*)(gate + (size_t)b * 6144 + c0 + bj * HALF + 4 * n) * mul;
#pragma unroll
        for (int ai = 0; ai < 2; ++ai) {
            f32x4 xv[4][2][2]; u32x4 xw[4][2];
#pragma unroll
            for (int m = 0; m < 4; ++m)
#pragma unroll
                for (int bj = 0; bj < 2; ++bj) { const size_t off = (size_t)(row0 + ai * HALF + m * 16) * 1024 + c0 + bj * HALF;
                    if (IN_F32) { xv[m][bj][0] = *(const f32x4*)(xin + off); xv[m][bj][1] = *(const f32x4*)(xin + off + 4); } else xw[m][bj] = *(const u32x4*)(xb + off); }
#pragma unroll
            for (int m = 0; m < 4; ++m)
#pragma unroll
                for (int bj = 0; bj < 2; ++bj) { const size_t off = (size_t)(row0 + ai * HALF + m * 16) * 1024 + c0 + bj * HALF;
                    f32x4 x0, x1; if (IN_F32) { x0 = xv[m][bj][0]; x1 = xv[m][bj][1]; } else unpack8(xw[m][bj], x0, x1);
                    *(u32x4*)(xb + off) = pack8(x0 + gv[bj][0] * acc[ai][bj][m][0], x1 + gv[bj][1] * acc[ai][bj][m][1]); }
        }
    }
};
template <bool F8, bool I8> struct EpiUp {
    static constexpr bool PERM = true; static constexpr bool TWO_SEG = false;
    bf16_t* Hid; const float* sa; const unsigned* cmax;
    __device__ __forceinline__ void operator()(const AccT& acc, const Unit& u, int wr, int wc, int fr, int fq) const {
        const int row0 = u.pm * BM + wr * 64 + fr, c0 = u.pn * 128 + wc * 32 + 8 * fq;
        f32x4 sbv[2][2];
        if (I8) {
#pragma unroll
            for (int bj = 0; bj < 2; ++bj)
#pragma unroll
                for (int n = 0; n < 2; ++n) { const u32x4 cb = *(const u32x4*)(cmax + u.pn * 256 + bj * HALF + wc * 32 + 8 * fq + 4 * n); sbv[bj][n] = (f32x4){__uint_as_float(cb.x), __uint_as_float(cb.y), __uint_as_float(cb.z), __uint_as_float(cb.w)}; }
        }
#pragma unroll
        for (int ai = 0; ai < 2; ++ai)
#pragma unroll
            for (int m = 0; m < 4; ++m) { f32x4 v0 = acc[ai][0][m][0], v1 = acc[ai][0][m][1]; f32x4 w0 = acc[ai][1][m][0], w1 = acc[ai][1][m][1];
                if (I8) { const float s = sa[row0 + ai * HALF + m * 16] * (1.0f / 127.0f);
                    v0 = i2f_4(v0) * (sbv[0][0] * s); v1 = i2f_4(v1) * (sbv[0][1] * s); w0 = i2f_4(w0) * (sbv[1][0] * s); w1 = i2f_4(w1) * (sbv[1][1] * s); }
                v0 = silu_mul_4(v0, w0); v1 = silu_mul_4(v1, w1);
                if (!F8) { *(u32x4*)(Hid + (size_t)(row0 + ai * HALF + m * 16) * DFF + c0) = pack8(v0, v1); continue; }
                int p0 = 0, p1 = 0; p0 = __builtin_amdgcn_cvt_pk_fp8_f32(v0[0], v0[1], p0, false); p0 = __builtin_amdgcn_cvt_pk_fp8_f32(v0[2], v0[3], p0, true);
                p1 = __builtin_amdgcn_cvt_pk_fp8_f32(v1[0], v1[1], p1, false); p1 = __builtin_amdgcn_cvt_pk_fp8_f32(v1[2], v1[3], p1, true);
                *(u32x2*)((unsigned char*)Hid + (size_t)(row0 + ai * HALF + m * 16) * DFF + c0) = (u32x2){(unsigned)p0, (unsigned)p1}; }
    }
};
struct EpiDown {
    static constexpr bool PERM = true; static constexpr bool TWO_SEG = false;
    bf16_t* xb; const float* gate; const int* rowlist; const float* slotw; const int* panel; float mul;
    __device__ __forceinline__ void operator()(const AccT& acc, const Unit& u, int wr, int wc, int fr, int fq) const {
        const int d = __builtin_amdgcn_readfirstlane(__hip_atomic_load(panel + u.pm, RLX_AGENT));
        const int ls0 = (d / 136) * SLOT_CAP + (d % 136) * 256 + wr * 64 + fr, c0 = (u.pn & 3) * 256 + wc * 32 + 8 * fq;
        int tok[2][4]; float wv[2][4];
#pragma unroll
        for (int ai = 0; ai < 2; ++ai)
#pragma unroll
            for (int m = 0; m < 4; ++m) { const int ls = ls0 + ai * HALF + m * 16; tok[ai][m] = __hip_atomic_load(rowlist + ls, RLX_AGENT); wv[ai][m] = __hip_atomic_load(slotw + ls, RLX_AGENT) * mul; }
#pragma unroll
        for (int ai = 0; ai < 2; ++ai)
#pragma unroll
            for (int mp = 0; mp < 2; ++mp) {
                u32x4 xw[2][2]; f32x4 gv[2][2][2];
#pragma unroll
                for (int mm = 0; mm < 2; ++mm) { const int m = 2 * mp + mm; const int token = tok[ai][m] < 0 ? 0 : tok[ai][m]; const int b = token >> 11;
#pragma unroll
                    for (int bj = 0; bj < 2; ++bj) { xw[mm][bj] = *(const u32x4*)(xb + (size_t)token * 1024 + c0 + bj * HALF);
#pragma unroll
                        for (int n = 0; n < 2; ++n) gv[mm][bj][n] = *(const f32x4*)(gate + (size_t)b * 6144 + c0 + bj * HALF + 4 * n); } }
#pragma unroll
                for (int mm = 0; mm < 2; ++mm) { const int m = 2 * mp + mm; const int token = tok[ai][m];
                    if (token >= 0) {
#pragma unroll
                        for (int bj = 0; bj < 2; ++bj) { f32x4 x0, x1; unpack8(xw[mm][bj], x0, x1);
                            x0 += (gv[mm][bj][0] * wv[ai][m]) * acc[ai][bj][m][0]; x1 += (gv[mm][bj][1] * wv[ai][m]) * acc[ai][bj][m][1];
                            *(u32x4*)(xb + (size_t)token * 1024 + c0 + bj * HALF) = pack8(x0, x1); } } }
            }
    }
};
struct EpiSlab {
    static constexpr bool PERM = false; static constexpr bool TWO_SEG = false;
    float* slab;
    __device__ __forceinline__ void operator()(const AccT& acc, const Unit& u, int wr, int wc, int fr, int fq) const {
        float* base = slab + ((size_t)(u.pn >> 2) * SLAB_ROWS + (size_t)(u.pm * BM + wr * 64 + fr)) * 1024 + (u.pn & 3) * 256 + wc * 32 + 4 * fq;
#pragma unroll
        for (int ai = 0; ai < 2; ++ai)
#pragma unroll
            for (int m = 0; m < 4; ++m)
#pragma unroll
                for (int bj = 0; bj < 2; ++bj)
#pragma unroll
                    for (int n = 0; n < 2; ++n) *(f32x4*)(base + (size_t)(ai * HALF + m * 16) * 1024 + bj * HALF + 16 * n) = acc[ai][bj][m][n];
    }
};
}
namespace attn_body {
using bf16=__hip_bfloat16;
using s16x4=__attribute__((ext_vector_type(4)))short;
using f32x16=__attribute__((ext_vector_type(16)))float;
constexpr int BATCH=16,NHEAD=8,SEQ=2048,D=64,DM=NHEAD*D;
constexpr int NW=8,QBLK=32,QB=QBLK*NW,KVBLK=64,NQB=SEQ/QB;
constexpr int ATTN_PITCH=DM, ATTN_UNIT_ROWS=QB;
typedef float f32x4v __attribute__((ext_vector_type(4)));
__device__ __forceinline__ int crow(int r,int hi){return (r&3)+8*(r>>2)+4*hi;}
#define SBAR() __builtin_amdgcn_sched_barrier(0)
__device__ __forceinline__ void cmask(f32x16&p0,f32x16&p1,int jb,int qrel,int hi){
  const float NEG=-INFINITY; int kb=64*jb+4*hi;
  #pragma unroll
  for(int r=0;r<16;++r){int kv=kb+(r&3)+8*(r>>2); if(kv>qrel)p0[r]=NEG; if(kv+32>qrel)p1[r]=NEG;}
}

constexpr int NSLOT=3, SLOTB=8192;
constexpr int LDS_K=0, LDS_V=NSLOT*SLOTB, LDS_WS=2*NSLOT*SLOTB, LDS_OST=LDS_WS+NW*64*4, LDS_F=LDS_OST+NW*4096, LDS_BYTES=LDS_F+SEQ*4;
constexpr float C2=0.125f*1.4426950408889634f;
__device__ __forceinline__ void glds16(const void*gsrc,unsigned lds_dst){unsigned keep;
  asm volatile("s_mov_b32 %0, m0\n\ts_mov_b32 m0, %2\n\ts_nop 0\n\tglobal_load_lds_dwordx4 %1, off\n\ts_mov_b32 m0, %0":"=&s"(keep):"v"(gsrc),"s"(lds_dst):"memory");}
__device__ __forceinline__ float max3f(float a,float b,float c){float r;asm("v_max3_f32 %0, %1, %2, %3":"=v"(r):"v"(a),"v"(b),"v"(c));return r;}
__device__ __forceinline__ float max2f(float a,float b){float r;asm("v_max_f32_e32 %0, %1, %2":"=v"(r):"v"(a),"v"(b));return r;}
__device__ __forceinline__ float fadd_s(float a,float b){float r;asm("v_add_f32_e32 %0, %1, %2":"=v"(r):"v"(a),"v"(b));return r;}
__device__ __forceinline__ float fsub_s(float a,float b){float r;asm("v_sub_f32_e32 %0, %1, %2":"=v"(r):"v"(a),"v"(b));return r;}
typedef float f32x2_t __attribute__((ext_vector_type(2))); typedef __bf16 bf16x2_t __attribute__((ext_vector_type(2)));
__device__ __forceinline__ unsigned cvtpk_s(float lo,float hi){f32x2_t v={lo,hi};bf16x2_t b=__builtin_convertvector(v,bf16x2_t);return __builtin_bit_cast(unsigned,b);}
#define WAIT_BAR(N) asm volatile("s_waitcnt vmcnt(" #N ") lgkmcnt(0)\n\ts_barrier":::"memory")

__device__ __forceinline__ void qkt(f32x16&p0,f32x16&p1,const char*Kslot,const bf16x8*qr,int r32,int hi){
  const char*kb=Kslot+hi*1024+r32*16;
  #pragma unroll
  for(int d0=0;d0<4;++d0){
    const bf16x8 b0=*reinterpret_cast<const bf16x8*>(kb+d0*2048);
    const bf16x8 b1=*reinterpret_cast<const bf16x8*>(kb+d0*2048+512);
    p0=__builtin_amdgcn_mfma_f32_32x32x16_bf16(b0,qr[d0],p0,0,0,0);p1=__builtin_amdgcn_mfma_f32_32x32x16_bf16(b1,qr[d0],p1,0,0,0);}
}
typedef __attribute__((address_space(3))) const char* lds_cptr;
typedef short v4i16_t __attribute__((ext_vector_type(4)));
__device__ __forceinline__ void kload8(bf16x8*kf,lds_cptr kp){
  kf[0]=*(const __attribute__((address_space(3))) bf16x8*)(kp);      kf[1]=*(const __attribute__((address_space(3))) bf16x8*)(kp+512);
  kf[2]=*(const __attribute__((address_space(3))) bf16x8*)(kp+2048); kf[3]=*(const __attribute__((address_space(3))) bf16x8*)(kp+2560);
  kf[4]=*(const __attribute__((address_space(3))) bf16x8*)(kp+4096); kf[5]=*(const __attribute__((address_space(3))) bf16x8*)(kp+4608);
  kf[6]=*(const __attribute__((address_space(3))) bf16x8*)(kp+6144); kf[7]=*(const __attribute__((address_space(3))) bf16x8*)(kp+6656);
}
__device__ __forceinline__ void kload2(bf16x8*kf,lds_cptr kp,int j){ kf[2*j]=*(const __attribute__((address_space(3))) bf16x8*)(kp+j*2048); kf[2*j+1]=*(const __attribute__((address_space(3))) bf16x8*)(kp+j*2048+512); }
__device__ __forceinline__ s16x4 vtr(lds_cptr p){ return __builtin_bit_cast(s16x4,__builtin_amdgcn_ds_read_tr16_b64_v4i16((__attribute__((address_space(3))) v4i16_t*)p)); }
__device__ __forceinline__ float rowmax(const f32x16&p0,const f32x16&p1){
  float a=max3f(p0[0],p0[1],p1[0]),b=max3f(p0[2],p0[3],p1[1]);a=max3f(a,p1[2],p1[3]);
  #pragma unroll
  for(int r=4;r<16;r+=4){a=max3f(a,p0[r],p0[r+1]);b=max3f(b,p0[r+2],p0[r+3]);a=max3f(a,p1[r],p1[r+1]);b=max3f(b,p1[r+2],p1[r+3]);}
  const float m=max2f(a,b);
  auto rr=__builtin_amdgcn_permlane32_swap(__float_as_uint(m),__float_as_uint(m),false,false);
  return max2f(__uint_as_float(rr[0]),__uint_as_float(rr[1]));
}
__device__ __forceinline__ void pv(f32x16*o,int vb,bf16x8 pa0,bf16x8 pa1,bf16x8 pa2,bf16x8 pa3){
  #pragma unroll
  for(int d0=0;d0<2;++d0){s16x4 lo[4],hi[4];
    #pragma unroll
    for(int ks=0;ks<4;++ks){
      asm volatile("ds_read_b64_tr_b16 %0,%1 offset:%c2":"=&v"(lo[ks]):"v"(vb),"i"(d0*4096+ks*1024):"memory");
      asm volatile("ds_read_b64_tr_b16 %0,%1 offset:%c2":"=&v"(hi[ks]):"v"(vb),"i"(d0*4096+ks*1024+512):"memory");}
    asm volatile("s_waitcnt lgkmcnt(0)":::"memory");SBAR();
    #define PK(k) (bf16x8){lo[k][0],lo[k][1],lo[k][2],lo[k][3],hi[k][0],hi[k][1],hi[k][2],hi[k][3]}
    o[d0]=__builtin_amdgcn_mfma_f32_32x32x16_bf16(pa0,PK(0),o[d0],0,0,0);
    o[d0]=__builtin_amdgcn_mfma_f32_32x32x16_bf16(pa1,PK(1),o[d0],0,0,0);
    o[d0]=__builtin_amdgcn_mfma_f32_32x32x16_bf16(pa2,PK(2),o[d0],0,0,0);
    o[d0]=__builtin_amdgcn_mfma_f32_32x32x16_bf16(pa3,PK(3),o[d0],0,0,0);
    #undef PK
  }
}

typedef __attribute__((address_space(3))) const f32x4v* lds_f4ptr;
__device__ __forceinline__ void binit1(f32x16&c,lds_f4ptr fp,float nq){
  #pragma unroll
  for(int g=0;g<4;++g){ const f32x4v a=fp[2*g];
    #pragma unroll
    for(int j=0;j<4;++j){ c[4*g+j]=nq-a[j]; } }
}
__device__ __forceinline__ void binit(f32x16&c0,f32x16&c1,lds_f4ptr fp,float nq){ binit1(c0,fp,nq); binit1(c1,fp+8,nq); }
#ifndef ATTN_STORE16
#define ATTN_STORE16(p,v) (*(u32x4*)(p)=(v))
#endif
template<int THRL> __device__ __forceinline__ void attn_unit(int b,int h,int qb,const bf16*Q,const bf16*__restrict__ K,const bf16*__restrict__ V,bf16*O,const float*Fl2,char*shm){
  int tid=threadIdx.x; asm volatile("":"+v"(tid)); const int lane=tid&63,r32=lane&31,hi=lane>>5; const int wid=__builtin_amdgcn_readfirstlane(tid>>6);
  const long rowbase=(long)b*SEQ; const int q0=qb*QB;
  const bf16*Qw=Q+(rowbase+q0+wid*QBLK)*DM+h*D;
  const bf16*Kh=K+rowbase*DM+h*D,*Vh=V+rowbase*DM+h*D;
  const unsigned lds0=(unsigned)(uintptr_t)shm;
  float*wsf=(float*)(shm+LDS_WS)+wid*64;
  const bf16*ksrc=Kh+(long)lane*DM+wid*8;
  const bf16*vsrc=Vh+(long)(16*(wid&3)+(lane>>2))*DM+(wid>>2)*32+(lane&3)*8;
  const unsigned kdst=lds0+LDS_K+wid*1024, vdst=lds0+LDS_V+wid*1024;
  #define DMA_K(t,slot) glds16(ksrc+(long)(t)*KVBLK*DM,(unsigned)__builtin_amdgcn_readfirstlane(kdst+(slot)))
  #define DMA_V(t,slot) glds16(vsrc+(long)(t)*KVBLK*DM,(unsigned)__builtin_amdgcn_readfirstlane(vdst+(slot)))
  const int vb0=(int)(lds0+LDS_V)+((lane>>4)&1)*32+(lane&3)*8+(4*hi+((lane&15)>>2))*64;
  const char*Kbase=shm+LDS_K; bf16x8 kf[8];
  const lds_cptr shm3=(lds_cptr)shm; const lds_cptr kp0=shm3+LDS_K+hi*1024+r32*16; const lds_cptr vp0=shm3+LDS_V+((lane>>4)&1)*32+(lane&3)*8+(4*hi+((lane&15)>>2))*64;
  const int NT=(q0+QB)/KVBLK;
  { const float*Fg=Fl2+(long)(b*NHEAD+h)*SEQ; const int i4=tid*4;
    if(i4<q0+QB){ const f32x4v fv=*reinterpret_cast<const f32x4v*>(Fg+i4); *(__attribute__((address_space(3))) f32x4v*)((__attribute__((address_space(3))) char*)shm3+LDS_F+i4*4)=fv; } }
  const lds_f4ptr fbase=(lds_f4ptr)(shm3+LDS_F+16*hi);
  DMA_K(0,0);DMA_V(0,0);DMA_K(1,SLOTB);
  bf16x8 qr[4];
  #pragma unroll
  for(int d0=0;d0<4;++d0)qr[d0]=*reinterpret_cast<const bf16x8*>(&Qw[(long)r32*DM+d0*16+hi*8]);
  float mhat=0.f,l_reg=0.f,nq=0.f,fq_l2=0.f;f32x16 o[2];o[0]=f32x16{};o[1]=f32x16{};
  const int qrel=wid*QBLK+r32;
  #define CMASK(P0,P1,t) do{int jb_=(t)-(NT-4); if(jb_>=0)cmask(P0,P1,jb_,qrel,hi);}while(0)
  bool resc=false;
  #define START(P0,P1) do{ const float rm=rowmax(P0,P1); resc=false; \
    { const float dl=rm; mhat=fadd_s(mhat,dl); \
      _Pragma("unroll") for(int r=0;r<16;++r){P0[r]=fsub_s(P0[r],dl);P1[r]=fsub_s(P1[r],dl);} \
      nq=fq_l2-mhat; } \
    _Pragma("unroll") for(int r=0;r<16;++r)P0[r]=__builtin_amdgcn_exp2f(P0[r]); }while(0)
  #define RESC() do{ if(resc){ asm volatile("s_waitcnt lgkmcnt(0)":::"memory"); \
      _Pragma("unroll") for(int d_=0;d_<2;++d_) _Pragma("unroll") for(int r=0;r<16;++r)o[d_][r]*=wsf[crow(r,hi)]; } }while(0)
  f32x16 pA0,pA1,pB0,pB1;
  int sl_prev=0,sl_cur=0,sl_next=SLOTB;
  #define ROT() do{sl_prev=sl_cur;sl_cur=sl_next;sl_next=(sl_next==(NSLOT-1)*SLOTB)?0:sl_next+SLOTB;}while(0)
  DMA_K(2,2*SLOTB);
  WAIT_BAR(3);
  fq_l2=*((__attribute__((address_space(3))) const float*)(shm3+LDS_F)+q0+qrel); nq=fq_l2;
  binit(pA0,pA1,fbase,nq);
  qkt(pA0,pA1,Kbase,qr,r32,hi);asm volatile("s_nop 15\n\ts_nop 7":"+v"(pA0),"+v"(pA1));CMASK(pA0,pA1,0);
  START(pA0,pA1);
  _Pragma("unroll") for(int r=0;r<16;++r)pA1[r]=__builtin_amdgcn_exp2f(pA1[r]);
  WAIT_BAR(0);
  DMA_K(3,0);DMA_V(1,SLOTB);
  ROT();
  kload8(kf,kp0+sl_cur);
  WAIT_BAR(2);
  s16x4 vlo[8],vhi[8]; u32x4 pw0,pw1,pw2,pw3;
  #define PKW(P,B) cvtpk_s(P[B],P[B+1])
  #define PAF(k) __builtin_bit_cast(bf16x8,pw##k)
  #define VFR(i) (bf16x8){vlo[i][0],vlo[i][1],vlo[i][2],vlo[i][3],vhi[i][0],vhi[i][1],vhi[i][2],vhi[i][3]}
  #define PIN(x) asm volatile("":"+v"(x))
  #define MX3(a,b,c) __builtin_fmaxf(__builtin_fmaxf((a),(b)),(c))
  #define GAPA(MF,A0,A1,A2,A3,W0,W1,PW) do{ MF; sacc+=A0; sacc+=A1; sacc+=A2; sacc+=A3; PIN(sacc); W0; W1; PIN(PW); SBAR(); }while(0)
  #define EX(v) __builtin_amdgcn_exp2f(v)
  #define GAPB(MF,X,B) do{ MF; X[B]=EX(X[B]); X[B+1]=EX(X[B+1]); X[B+2]=EX(X[B+2]); X[B+3]=EX(X[B+3]); PIN(X); SBAR(); }while(0)
  #define VRD(i) do{ vlo[i]=vtr(vp_+(((i)>>2)*4096+((i)&3)*1024)); vhi[i]=vtr(vp_+(((i)>>2)*4096+((i)&3)*1024+512)); }while(0)
  #define KRD(G,j) do{ if(G){ kload2(kf,kp0+sl_next,j); SBAR(); } }while(0)
  #define STEP(C0,C1,P0,P1,t,GK,GV,GL) do{ const lds_f4ptr fp_=(lds_f4ptr)((lds_cptr)fbase+256*(t)); binit1(C0,fp_,nq); SBAR(); \
    const lds_cptr vp_=vp0+sl_prev; \
    VRD(0); SBAR(); float sacc=(P0[0]+P0[1]); \
    GAPA(C0=__builtin_amdgcn_mfma_f32_32x32x16_bf16(kf[0],qr[0],C0,0,0,0), P0[2],P0[3],P0[4],P0[5],     pw0[0]=PKW(P0,0), pw0[1]=PKW(P0,2), pw0); \
    binit1(C1,fp_+8,nq); VRD(4); SBAR(); GAPA(C1=__builtin_amdgcn_mfma_f32_32x32x16_bf16(kf[1],qr[0],C1,0,0,0), P0[6],P0[7],P0[8],P0[9],     pw0[2]=PKW(P0,4), pw0[3]=PKW(P0,6), pw0); \
    VRD(1); SBAR(); GAPA(C0=__builtin_amdgcn_mfma_f32_32x32x16_bf16(kf[2],qr[1],C0,0,0,0),   P0[10],P0[11],P0[12],P0[13], pw1[0]=PKW(P0,8), pw1[1]=PKW(P0,10), pw1); \
    VRD(5); SBAR(); GAPA(C1=__builtin_amdgcn_mfma_f32_32x32x16_bf16(kf[3],qr[1],C1,0,0,0),   P0[14],P0[15],P1[0],P1[1],   pw1[2]=PKW(P0,12),pw1[3]=PKW(P0,14), pw1); \
    VRD(2); SBAR(); GAPA(C0=__builtin_amdgcn_mfma_f32_32x32x16_bf16(kf[4],qr[2],C0,0,0,0),   P1[2],P1[3],P1[4],P1[5],     pw2[0]=PKW(P1,0), pw2[1]=PKW(P1,2), pw2); \
    VRD(6); SBAR(); GAPA(C1=__builtin_amdgcn_mfma_f32_32x32x16_bf16(kf[5],qr[2],C1,0,0,0),   P1[6],P1[7],P1[8],P1[9],     pw2[2]=PKW(P1,4), pw2[3]=PKW(P1,6), pw2); \
    VRD(3); SBAR(); GAPA(C0=__builtin_amdgcn_mfma_f32_32x32x16_bf16(kf[6],qr[3],C0,0,0,0),   P1[10],P1[11],P1[12],P1[13], pw3[0]=PKW(P1,8), pw3[1]=PKW(P1,10), pw3); \
    VRD(7); SBAR(); GAPA(C1=__builtin_amdgcn_mfma_f32_32x32x16_bf16(kf[7],qr[3],C1,0,0,0),   P1[14],P1[15],0.f,0.f,       pw3[2]=PKW(P1,12),pw3[3]=PKW(P1,14), pw3); \
    l_reg+=sacc; \
    if(GK){DMA_K((t)+3,sl_cur);} if(GV){DMA_V((t)+1,sl_next);} \
    CMASK(C0,C1,t); \
    { float a=MX3(C0[0],C0[1],C1[0]),b=MX3(C0[2],C0[3],C1[1]); a=MX3(a,C1[2],C1[3]); \
      _Pragma("unroll") for(int r=4;r<16;r+=4){a=MX3(a,C0[r],C0[r+1]);b=MX3(b,C0[r+2],C0[r+3]);a=MX3(a,C1[r],C1[r+1]);b=MX3(b,C1[r+2],C1[r+3]);} \
      float rm=__builtin_fmaxf(a,b); { auto rr=__builtin_amdgcn_permlane32_swap(__float_as_uint(rm),__float_as_uint(rm),false,false); rm=__builtin_fmaxf(__uint_as_float(rr[0]),__uint_as_float(rr[1])); } \
      resc=false; \
      if(__builtin_expect(__any(rm>(float)THRL),0)){ const float dl=__builtin_fmaxf(rm,0.f); mhat+=dl; \
        _Pragma("unroll") for(int r=0;r<16;++r){C0[r]-=dl;C1[r]-=dl;} \
        nq=fq_l2-mhat; \
        const float f=__builtin_amdgcn_exp2f(-dl); l_reg*=f; if(hi==0)wsf[r32]=f; resc=true; } } \
    SBAR(); \
    GAPB(o[0]=__builtin_amdgcn_mfma_f32_32x32x16_bf16(PAF(0),VFR(0),o[0],0,0,0), C0,0); \
    GAPB(o[1]=__builtin_amdgcn_mfma_f32_32x32x16_bf16(PAF(0),VFR(4),o[1],0,0,0), C0,4); \
    KRD(GL,0); GAPB(o[0]=__builtin_amdgcn_mfma_f32_32x32x16_bf16(PAF(1),VFR(1),o[0],0,0,0), C0,8); \
    KRD(GL,1); GAPB(o[1]=__builtin_amdgcn_mfma_f32_32x32x16_bf16(PAF(1),VFR(5),o[1],0,0,0), C0,12); \
    KRD(GL,2); GAPB(o[0]=__builtin_amdgcn_mfma_f32_32x32x16_bf16(PAF(2),VFR(2),o[0],0,0,0), C1,0); \
    KRD(GL,3); GAPB(o[1]=__builtin_amdgcn_mfma_f32_32x32x16_bf16(PAF(2),VFR(6),o[1],0,0,0), C1,4); \
    GAPB(o[0]=__builtin_amdgcn_mfma_f32_32x32x16_bf16(PAF(3),VFR(3),o[0],0,0,0), C1,8); \
    GAPB(o[1]=__builtin_amdgcn_mfma_f32_32x32x16_bf16(PAF(3),VFR(7),o[1],0,0,0), C1,12); \
    }while(0)
  int t=1;
  #undef CMASK
  #define CMASK(P0,P1,t) do{}while(0)
  for(;t+5<NT;t+=2){
    STEP(pB0,pB1,pA0,pA1,t,true,true,true);     WAIT_BAR(2); RESC(); ROT();
    STEP(pA0,pA1,pB0,pB1,t+1,true,true,true);   WAIT_BAR(2); RESC(); ROT();
  }
  #undef CMASK
  #define CMASK(P0,P1,t) do{int jb_=(t)-(NT-4); if(jb_>=0)cmask(P0,P1,jb_,qrel,hi);}while(0)
  #define ENDW(tt) do{ if((tt)+3<NT){WAIT_BAR(2);} else if((tt)+2<NT){WAIT_BAR(1);} else {WAIT_BAR(0);} }while(0)
  for(;t+1<NT;t+=2){
    STEP(pB0,pB1,pA0,pA1,t,(t+3<NT),(t+1<NT),(t+1<NT));       ENDW(t);   RESC(); ROT();
    STEP(pA0,pA1,pB0,pB1,t+1,(t+4<NT),(t+2<NT),(t+2<NT));     ENDW(t+1); RESC(); ROT();
  }
  STEP(pB0,pB1,pA0,pA1,NT-1,false,false,false); RESC();
  { float sacc=pB0[0]+pB0[1]; _Pragma("unroll") for(int r=2;r<16;++r)sacc+=pB0[r]; _Pragma("unroll") for(int r=0;r<16;++r)sacc+=pB1[r]; l_reg+=sacc;
    pw0=(u32x4){PKW(pB0,0),PKW(pB0,2),PKW(pB0,4),PKW(pB0,6)};pw1=(u32x4){PKW(pB0,8),PKW(pB0,10),PKW(pB0,12),PKW(pB0,14)};pw2=(u32x4){PKW(pB1,0),PKW(pB1,2),PKW(pB1,4),PKW(pB1,6)};pw3=(u32x4){PKW(pB1,8),PKW(pB1,10),PKW(pB1,12),PKW(pB1,14)};
    SBAR(); pv(o,vb0+sl_cur,PAF(0),PAF(1),PAF(2),PAF(3)); }
  #undef PKW
  #undef PAF
  #undef VFR
  #undef PIN
  #undef MX3
  #undef GAPA
  #undef GAPB
  #undef EX
  #undef VRD
  #undef KRD
  #undef STEP
  #undef ENDW
  {auto rr=__builtin_amdgcn_permlane32_swap(__float_as_uint(l_reg),__float_as_uint(l_reg),false,false);l_reg=__uint_as_float(rr[0])+__uint_as_float(rr[1]);}
  if(hi==0)wsf[32+r32]=l_reg;asm volatile("s_waitcnt lgkmcnt(0)":::"memory");
  float rli[16];
  #pragma unroll
  for(int r=0;r<16;++r)rli[r]=__builtin_amdgcn_rcpf(wsf[32+crow(r,hi)]);
  bf16*Ow=O+(rowbase+q0+wid*QBLK)*DM+h*D;
  { bf16*stg=(bf16*)(shm+LDS_OST)+wid*2048;
    #pragma unroll
    for(int r=0;r<16;++r){const int orow=crow(r,hi);
      #pragma unroll
      for(int d0=0;d0<2;++d0)stg[orow*64+d0*32+r32]=__float2bfloat16(o[d0][r]*rli[r]);}
    asm volatile("s_waitcnt lgkmcnt(0)":::"memory");
    #pragma unroll
    for(int i=0;i<4;++i){const int row=i*8+(lane>>3),ch=lane&7; const u32x4 v=*(const u32x4*)(stg+row*64+ch*8); ATTN_STORE16(Ow+(long)row*DM+ch*8,v);} }
  asm volatile("s_waitcnt lgkmcnt(0)\n\ts_barrier":::"memory");
  #undef DMA_K
  #undef DMA_V
  #undef CMASK
  #undef START
  #undef RESC
  #undef ROT
}
constexpr int ATTN_LDS_BYTES=LDS_BYTES;
struct AttnTensors { const bf16* Q; const bf16* K; const bf16* V; bf16* O; const float* Fl2; };
struct AttnUnit { int bh; int qb; };
struct StaticOrder {
  int vcu;
  __device__ __forceinline__ explicit StaticOrder(int grid,int block):vcu((block%8)*(grid/8)+block/8){}
  __device__ __forceinline__ bool next(int i,AttnUnit&u)const{ if(i>=4||vcu>=256)return false; const int a=2*(vcu&1)+(i>>1); u.bh=vcu>>1; u.qb=(i&1)?7-a:a; return true; }
  __device__ __forceinline__ void a_ready(const AttnUnit&)const{}
  __device__ __forceinline__ void done(const AttnUnit&)const{}
};
template<class Sched,int THRL=40> __device__ __forceinline__ void attn_phase(char*lds,const AttnTensors&T,const Sched&S){
  AttnUnit u;
  for(int i=0;S.next(i,u);++i){ S.a_ready(u); attn_unit<THRL>(u.bh/NHEAD,u.bh%NHEAD,u.qb,T.Q,T.K,T.V,T.O,T.Fl2,lds); S.done(u); }
}
#undef SBAR
#undef WAIT_BAR
}

constexpr int RING_OFF = 0, RING_BYTES = 131072;
constexpr int LDSCTL_OFF = RING_BYTES, MISC_OFF = LDSCTL_OFF + 320;
constexpr int LDS_BYTES = 147456;
constexpr int NWAVES = 8;
static_assert(attn_body::ATTN_LDS_BYTES <= RING_BYTES, "attention scratch");

#define XB_TMO      128
#define XB_XCNT(j)  (256  + 64 * (j))
#define XB_XSUB(j)  (1280 + 64 * (j))
#define XB_XGEN(j)  (2304 + 64 * (j))
#define XB_TOP      3328
#define XB_TOPGEN   3392
#define XCD_BAR_WORDS 3456
#define XB_SPIN_CAP (1u << 18)
__device__ __forceinline__ unsigned xb_ld(unsigned* p)              { return __hip_atomic_load(p, __ATOMIC_RELAXED, __HIP_MEMORY_SCOPE_AGENT); }
__device__ __forceinline__ unsigned xb_add(unsigned* p, unsigned v) { return __hip_atomic_fetch_add(p, v, __ATOMIC_RELAXED, __HIP_MEMORY_SCOPE_AGENT); }
__device__ __forceinline__ unsigned xb_xcc_id() { return (unsigned)__builtin_amdgcn_s_getreg((3 << 11) | 20) & 0xFu; }
#define XB_SPIN(cond, bar) do { unsigned _sp = 0; while (cond) { __builtin_amdgcn_s_sleep(1); \
    if ((++_sp & 255u) == 0u) { if (xb_ld(&(bar)[XB_TMO])) break; if (_sp > XB_SPIN_CAP) { atomicAdd(&(bar)[XB_TMO], 1u); break; } } } } while (0)
struct XcdBarrier { unsigned* bar; unsigned x; volatile LAS unsigned* st; };
__device__ __forceinline__ XcdBarrier xcd_barrier_post(unsigned* bar, volatile LAS unsigned* st) {
    XcdBarrier b; b.bar = bar; b.x = xb_xcc_id(); b.st = st;
    if (threadIdx.x == 0) (void)xb_add(&bar[XB_XCNT(b.x)], 1u);
    return b;
}
__device__ __forceinline__ void xcd_barrier_complete(unsigned* bar, unsigned x, unsigned& nloc, unsigned& nx) {
    const unsigned G = gridDim.x * gridDim.y * gridDim.z;
    unsigned sum, cnt, mine, sp = 0u;
    for (;;) {
        sum = 0u; cnt = 0u; mine = 0u;
#pragma unroll
        for (unsigned j = 0; j < 16; ++j) { const unsigned c = xb_ld(&bar[XB_XCNT(j)]); sum += c; cnt += (c > 0u) ? 1u : 0u; mine = (j == x) ? c : mine; }
        if (sum == G) break;
        __builtin_amdgcn_s_sleep(1);
        if ((++sp & 255u) == 0u) { if (xb_ld(&bar[XB_TMO])) break; if (sp > XB_SPIN_CAP) { atomicAdd(&bar[XB_TMO], 1u); break; } }
    }
    nloc = mine > 0u ? mine : 1u; nx = cnt > 0u ? cnt : 1u;
}
__device__ __forceinline__ void xcd_barrier(const XcdBarrier& b) {
    asm volatile("s_waitcnt vmcnt(0)" ::: "memory");
    __syncthreads();
    if (threadIdx.x == 0) {
        unsigned* bar = b.bar;
        __builtin_amdgcn_s_waitcnt(0);
        unsigned nloc = b.st[0], nx = b.st[1];
        if (nloc == 0u) { xcd_barrier_complete(bar, b.x, nloc, nx); b.st[0] = nloc; b.st[1] = nx; }
        const unsigned old = xb_add(&bar[XB_XSUB(b.x)], 1u);
        const unsigned gen = old / nloc;
        if (old + 1u == (gen + 1u) * nloc) {
            __builtin_amdgcn_fence(__ATOMIC_RELEASE, "agent");
            asm volatile("s_waitcnt vmcnt(0)" ::: "memory");
            const unsigned og = xb_add(&bar[XB_TOP], 1u);
            const unsigned tg = og / nx;
            if (og + 1u == (tg + 1u) * nx) xb_add(&bar[XB_TOPGEN], 1u);
            else XB_SPIN(xb_ld(&bar[XB_TOPGEN]) == tg, bar);
            __builtin_amdgcn_fence(__ATOMIC_ACQUIRE, "agent");
            xb_add(&bar[XB_XGEN(b.x)], 1u);
            asm volatile("s_waitcnt vmcnt(0)" ::: "memory");
        } else {
            XB_SPIN(xb_ld(&bar[XB_XGEN(b.x)]) == gen, bar);
            __builtin_amdgcn_fence(__ATOMIC_ACQUIRE, "agent");
            asm volatile("s_waitcnt vmcnt(0)" ::: "memory");
        }
    }
    __syncthreads();
}

__device__ __forceinline__ void* ld_ptr(LAS unsigned long long* PT, int i) { const volatile LAS unsigned* p = (const volatile LAS unsigned*)(PT + i); const unsigned lo = __builtin_amdgcn_readfirstlane(p[0]), hi = __builtin_amdgcn_readfirstlane(p[1]); return (void*)(GAS void*)(((unsigned long long)hi << 32) | lo); }
struct TrItem { const float* W; bf16_t* WT; int pitch, srccol0, Kd, dstrow0, k0, f8; unsigned char* WT8; };
__device__ __forceinline__ void tr_load(f32x4 (&v)[16], const TrItem& t, int lane) {
    const int lr = lane >> 4, lc = 4 * (lane & 15);
#pragma unroll
    for (int j = 0; j < 16; ++j) v[j] = *(const GAS f32x4*)(t.W + (size_t)(t.k0 + 16 * lr + j) * t.pitch + t.srccol0 + lc);
}
__device__ __forceinline__ void tr_store(const f32x4 (&v)[16], const TrItem& t, int lane) {
    const int lr = lane >> 4, lc = 4 * (lane & 15);
    const size_t eoff = (size_t)(t.dstrow0 + lc) * t.Kd + t.k0 + 16 * lr;
    if (t.f8 == 1 || t.f8 == 2) {
        GAS unsigned char* dst8 = (GAS unsigned char*)(t.f8 == 2 ? t.WT8 : (unsigned char*)t.WT) + eoff;
#pragma unroll
        for (int q = 0; q < 4; ++q) { u32x4 o;
#pragma unroll
            for (int w = 0; w < 4; ++w) { int pw = 0; pw = __builtin_amdgcn_cvt_pk_fp8_f32(64.f * v[4 * w][q], 64.f * v[4 * w + 1][q], pw, false); pw = __builtin_amdgcn_cvt_pk_fp8_f32(64.f * v[4 * w + 2][q], 64.f * v[4 * w + 3][q], pw, true); o[w] = (unsigned)pw; }
            *(GAS u32x4*)(dst8 + (size_t)q * t.Kd) = o; }
    }
    if (t.f8 == 3) {
        const f32x4 cm = *(const GAS f32x4*)((const GAS float*)t.WT8 + t.dstrow0 + lc);
        GAS unsigned char* dst8 = (GAS unsigned char*)t.WT + eoff;
#pragma unroll
        for (int q = 0; q < 4; ++q) { const float qs = 127.0f / fmaxf(cm[q], 1e-30f); u32x4 o;
#pragma unroll
            for (int w = 0; w < 4; ++w) o[w] = pack_i8(qs * v[4 * w][q], qs * v[4 * w + 1][q], qs * v[4 * w + 2][q], qs * v[4 * w + 3][q]);
            *(GAS u32x4*)(dst8 + (size_t)q * t.Kd) = o; }
    }
    if (t.f8 == 0 || t.f8 == 2) {
        GAS bf16_t* dst = (GAS bf16_t*)t.WT + eoff;
#pragma unroll
        for (int q = 0; q < 4; ++q) { u32x4 o0, o1;
#pragma unroll
            for (int w = 0; w < 4; ++w) { o0[w] = pk2(v[2 * w][q], v[2 * w + 1][q]); o1[w] = pk2(v[8 + 2 * w][q], v[8 + 2 * w + 1][q]); }
            *(GAS u32x4*)(dst + (size_t)q * t.Kd) = o0; *(GAS u32x4*)(dst + (size_t)q * t.Kd + 8) = o1; }
    }
}
__device__ __forceinline__ int up_row(int n0, int which) { return (n0 >> 7) * 256 + (n0 & 127) + which * 128; }

constexpr size_t WIN_LSTRIDE = (size_t)3 * 1024 * 1024;
struct P0Ptrs { const float *w_in, *w_glu, *w_pa, *w_ps, *w_out, *w1d, *w3d, *w2d; bf16_t *WIN, *WGLU, *WPA, *WPS, *WOUT, *WUPD, *WDND; float* CMAX; };
constexpr int TI_IN = 16 * 64, TI_GLU = 8 * 8, TI_P = 8 * 16, TI_O = 16 * 16, TI_L = TI_IN + TI_GLU + 2 * TI_P + TI_O, TI_UP = 16 * 44, TI_DN = 44 * 16, TI_P0 = 2 * TI_L + 2 * TI_UP + TI_DN, TI_E = 2 * TI_UP + TI_DN;
__device__ __forceinline__ void make_p0_item(TrItem& t, int it, const P0Ptrs& P) {
    int r = it;
    if (r < 2 * TI_L) { const int l = r / TI_L; r -= l * TI_L;
        if (r < TI_IN) { const int kb = r / 64, nb = r % 64, n0 = 64 * nb;
            t = TrItem{P.w_in + (size_t)l * 1024 * NIN_SRC, P.WIN + (size_t)l * WIN_LSTRIDE, NIN_SRC, n0 < 1536 ? n0 : n0 + 8, 1024, n0, 64 * kb, 3, (unsigned char*)(P.CMAX + l * 4096)}; return; } r -= TI_IN;
        if (r < TI_GLU) { const int kb = r / 8, nb = r % 8; t = TrItem{P.w_glu + (size_t)l * 512 * 512, P.WGLU + (size_t)l * 512 * 512, 512, 64 * nb, 512, 64 * nb, 64 * kb, 0, nullptr}; return; } r -= TI_GLU;
        if (r < TI_P) { const int kb = r / 16, nb = r % 16; t = TrItem{P.w_pa + (size_t)l * 512 * 1024, P.WPA + (size_t)l * 1024 * 512, 1024, 64 * nb, 512, 64 * nb, 64 * kb, 0, nullptr}; return; } r -= TI_P;
        if (r < TI_P) { const int kb = r / 16, nb = r % 16; t = TrItem{P.w_ps + (size_t)l * 512 * 1024, P.WPS + (size_t)l * 1024 * 512, 1024, 64 * nb, 512, 64 * nb, 64 * kb, 0, nullptr}; return; } r -= TI_P;
        { const int kb = r / 16, nb = r % 16; t = TrItem{P.w_out + (size_t)l * 1024 * 1024, P.WOUT + (size_t)l * 1024 * 1024, 1024, 64 * nb, 1024, 64 * nb, 64 * kb, 0, nullptr}; return; }
    }
    r -= 2 * TI_L;
    if (r < TI_UP) { const int kb = r / 44, nb = r % 44; t = TrItem{P.w1d, P.WUPD, DFF, 64 * nb, 1024, up_row(64 * nb, 0), 64 * kb, 3, (unsigned char*)(P.CMAX + 8192)}; return; } r -= TI_UP;
    if (r < TI_UP) { const int kb = r / 44, nb = r % 44; t = TrItem{P.w3d, P.WUPD, DFF, 64 * nb, 1024, up_row(64 * nb, 1), 64 * kb, 3, (unsigned char*)(P.CMAX + 8192)}; return; } r -= TI_UP;
    { const int kb = r / 16, nb = r % 16; t = TrItem{P.w2d, P.WDND, 1024, 64 * nb, DFF, 64 * nb, 64 * kb, DENSE_DOWN_FP8, nullptr}; }
}
struct MoePtrs { const float *w1m, *w3m, *w2m; bf16_t *WUPM, *WDNM; unsigned char* WUP8; };
constexpr int MOE_ROUNDS_UP = 8 * 2 * 11 * 8, MOE_ROUNDS = MOE_ROUNDS_UP + 8 * 8 * 11;
constexpr int MOE_R_S5 = 3, MOE_R_SORT0 = 2 * 112 * MOE_R_S5, MOE_R_NORM0 = MOE_R_SORT0 + 255, MOE_R_NORM_EACH = 4, MOE_R_TAIL0 = MOE_R_NORM0 + 256 * MOE_R_NORM_EACH;
static_assert(MOE_R_TAIL0 <= MOE_ROUNDS && MOE_ROUNDS - MOE_R_TAIL0 <= 256, "MoE conversion shares");
__device__ __forceinline__ void make_moe_item(TrItem& t, int it, const MoePtrs& P) {
    const int rho = it >> 3, w = it & 7;
    if (rho < MOE_ROUNDS_UP) { const int tile = rho >> 3, i = rho & 7, e = tile / 22, rem = tile % 22, which = rem / 11, nb = 4 * (rem % 11) + (w & 3), kb = 2 * i + (w >> 2);
        t = TrItem{(which ? P.w3m : P.w1m) + (size_t)e * 1024 * DFF, (bf16_t*)(P.WUP8 + (size_t)e * 5632 * 1024), DFF, 64 * nb, 1024, up_row(64 * nb, which), 64 * kb, 1, nullptr}; return; }
    { const int r2 = rho - MOE_ROUNDS_UP, tile = r2 / 11, i = r2 % 11, e = tile >> 3, rem = tile & 7, nb = 4 * (rem >> 1) + (w & 3), kb = 22 * (rem & 1) + 2 * i + (w >> 2);
        t = TrItem{P.w2m + (size_t)e * DFF * 1024, P.WDNM + (size_t)e * 512 * DFF, 1024, 64 * nb, DFF, 64 * nb, 64 * kb, 1, nullptr}; }
}
__device__ __forceinline__ void colmax_item(LAS unsigned char* lds, int tid, const float* W, int pitch, int srccol0, float* out) {
    const int q = tid & 15, r = tid >> 4; f32x4 m = (f32x4){0.f, 0.f, 0.f, 0.f};
    for (int i0 = 0; i0 < 32; i0 += 8) { f32x4 v[8];
#pragma unroll
        for (int j = 0; j < 8; ++j) v[j] = *(const GAS f32x4*)(W + (size_t)(r + 32 * (i0 + j)) * pitch + srccol0 + 4 * q);
#pragma unroll
        for (int j = 0; j < 8; ++j) { m[0] = fmaxf(m[0], fabsf(v[j][0])); m[1] = fmaxf(m[1], fabsf(v[j][1])); m[2] = fmaxf(m[2], fabsf(v[j][2])); m[3] = fmaxf(m[3], fabsf(v[j][3])); } }
    LAS float* red = (LAS float*)lds;
    *(LAS f32x4*)(red + r * 64 + 4 * q) = m;
    LDS_WAIT(); __syncthreads();
    if (tid < 64) { float mm = 0.f;
#pragma unroll
        for (int rr = 0; rr < 32; ++rr) mm = fmaxf(mm, red[rr * 64 + tid]);
        out[tid] = mm; }
    LDS_WAIT(); __syncthreads();
}
constexpr int CM_ITEMS = 128 + 88;
#define TR_LOOP(FIRST, N, STRIDE, MAKE, PTRS) do { int it_ = (FIRST); TrItem ta_, tb_; f32x4 va_[16], vb_[16]; \
    if (it_ < (N)) { MAKE(ta_, it_, PTRS); tr_load(va_, ta_, lane); } \
    while (it_ < (N)) { const int i2_ = it_ + (STRIDE); if (i2_ < (N)) { MAKE(tb_, i2_, PTRS); tr_load(vb_, tb_, lane); } tr_store(va_, ta_, lane); \
        if (i2_ >= (N)) break; const int i3_ = i2_ + (STRIDE); if (i3_ < (N)) { MAKE(ta_, i3_, PTRS); tr_load(va_, ta_, lane); } tr_store(vb_, tb_, lane); it_ = i3_; } } while (0)

__device__ __forceinline__ void s5_gen(LAS unsigned char* lds, int tid, const float* lam_re, const float* lam_im, const float* log_dt, const float* b_re, const float* b_im,
                                       const float* c_re, const float* c_im, bf16_t* TG, bf16_t* WST, float* A32) {
    constexpr int GS = 65, KT = 20, KH = 32 * KT;
    LAS float* Gre = (LAS float*)lds;
    LAS float* Gim = Gre + 33 * GS + 3;
    LAS float* Bbr = Gim + 33 * GS + 3;
    LAS float* Bbi = Bbr + 1024;
    LAS float* CrT = Bbi + 1024;
    LAS float* CiT = CrT + 1024;
    LAS float* kk = CiT + 1024;
    LAS float* Kt = kk + 128 + 28;
    const double dt = exp((double)log_dt[0]);
    { const int p = tid & 63, sl = tid >> 6;
        const double lr = (double)lam_re[p], li = (double)lam_im[p];
        for (int tau = sl; tau <= 32; tau += 8) { const double mg = exp(lr * dt * (double)tau), ang = li * dt * (double)tau; double sn, cs; sincos(ang, &sn, &cs);
            Gre[tau * GS + p] = (float)(mg * cs); Gim[tau * GS + p] = (float)(mg * sn);
            if (tau == 32) { A32[2 * p] = (float)(mg * cs); A32[2 * p + 1] = (float)(mg * sn); } }
        if (sl == 0) { const double mg = exp(lr * dt), ang = li * dt; double sn, cs; sincos(ang, &sn, &cs); const double nr = mg * cs - 1.0, ni = mg * sn, den = lr * lr + li * li;
            kk[2 * p] = (float)((nr * lr + ni * li) / den); kk[2 * p + 1] = (float)((ni * lr - nr * li) / den); } }
    for (int i = tid; i < 1024; i += 512) { const int ho = i >> 6, p = i & 63; CrT[p * 16 + ho] = c_re[i]; CiT[p * 16 + ho] = c_im[i]; }
    LDS_WAIT(); __syncthreads();
    for (int i = tid; i < 1024; i += 512) { const int p = i >> 4; const float kr = kk[2 * p], ki = kk[2 * p + 1], br = b_re[i], bi = b_im[i]; Bbr[i] = kr * br - ki * bi; Bbi[i] = kr * bi + ki * br; }
    LDS_WAIT(); __syncthreads();
    {
        const int tau = tid >> 4, ho = tid & 15; f32x2 a2[8];
#pragma unroll
        for (int i = 0; i < 8; ++i) a2[i] = (f32x2){0.f, 0.f};
        for (int p0 = 0; p0 < 64; p0 += 4) { float er[4], ei[4];
#pragma unroll
            for (int pp = 0; pp < 4; ++pp) { const int p = p0 + pp; const float cr = CrT[p * 16 + ho], ci = CiT[p * 16 + ho], gr = Gre[tau * GS + p], gi = Gim[tau * GS + p];
                er[pp] = cr * gr - ci * gi; ei[pp] = -(cr * gi + ci * gr); }
#pragma unroll
            for (int pp = 0; pp < 4; ++pp) { const LAS f32x4* br4 = (const LAS f32x4*)(Bbr + (p0 + pp) * 16); const LAS f32x4* bi4 = (const LAS f32x4*)(Bbi + (p0 + pp) * 16);
                const f32x2 e2 = (f32x2){er[pp], er[pp]}, f2 = (f32x2){ei[pp], ei[pp]};
#pragma unroll
                for (int q = 0; q < 4; ++q) { const f32x4 br = br4[q], bi = bi4[q];
                    a2[2 * q] += e2 * (f32x2){br[0], br[1]} + f2 * (f32x2){bi[0], bi[1]}; a2[2 * q + 1] += e2 * (f32x2){br[2], br[3]} + f2 * (f32x2){bi[2], bi[3]}; } } }
        LAS f32x4* kd = (LAS f32x4*)(Kt + ho * KH + tau * KT);
#pragma unroll
        for (int q = 0; q < 4; ++q) kd[q] = (f32x4){a2[2 * q][0], a2[2 * q][1], a2[2 * q + 1][0], a2[2 * q + 1][1]}; }
    {
        for (int pc = tid; pc < 128 * 64; pc += 512) { const int n = pc >> 6, c = pc & 63, p = n >> 1, ri = n & 1, j = c >> 1, h8 = 8 * (c & 1);
            const float gr = Gre[(31 - j) * GS + p], gi = Gim[(31 - j) * GS + p]; float v[8];
#pragma unroll
            for (int hi = 0; hi < 8; ++hi) { const float br = Bbr[p * 16 + h8 + hi], bi = Bbi[p * 16 + h8 + hi]; v[hi] = ri ? (gr * bi + gi * br) : (gr * br - gi * bi); }
            u32x4 o; o.x = pk2(v[0], v[1]); o.y = pk2(v[2], v[3]); o.z = pk2(v[4], v[5]); o.w = pk2(v[6], v[7]);
            *(GAS u32x4*)(WST + (size_t)pc * 8) = o; }
        const u32x4 z = (u32x4){0u, 0u, 0u, 0u};
        for (int i = tid; i < 128 * 512 / 8; i += 512) *(GAS u32x4*)(WST + (size_t)128 * 512 + (size_t)i * 8) = z; }
    LDS_WAIT(); __syncthreads();
    {
#pragma unroll 2
        for (int row = tid >> 6; row < 512; row += 8) { const int cp = tid & 63, t = row >> 4, ho = row & 15, s = cp >> 1; u32x4 o = (u32x4){0u, 0u, 0u, 0u};
            if (s <= t) { const LAS f32x4* kp = (const LAS f32x4*)(Kt + ho * KH + (t - s) * KT + 8 * (cp & 1)); const f32x4 k0 = kp[0], k1 = kp[1];
                o.x = pk2(k0[0], k0[1]); o.y = pk2(k0[2], k0[3]); o.z = pk2(k1[0], k1[1]); o.w = pk2(k1[2], k1[3]); }
            *(GAS u32x4*)(TG + (size_t)row * 640 + cp * 8) = o; }
#pragma unroll 2
        for (int pc = tid; pc < 512 * 16; pc += 512) { const int row = pc >> 4, p4 = 4 * (pc & 15), t = row >> 4, ho = row & 15; u32x4 o;
#pragma unroll
            for (int pp = 0; pp < 4; ++pp) { const int p = p4 + pp; const float cr = CrT[p * 16 + ho], ci = CiT[p * 16 + ho], g1r = Gre[(t + 1) * GS + p], g1i = Gim[(t + 1) * GS + p];
                o[pp] = pk2(cr * g1r - ci * g1i, -(cr * g1i + ci * g1r)); }
            *(GAS u32x4*)(TG + (size_t)row * 640 + 512 + 2 * p4) = o; } }
    LDS_WAIT(); __syncthreads();
}

__device__ __forceinline__ void ada_item(LAS unsigned char* lds, int tid, const float* c, const float* W, const float* bias, float* ada_l, int cg) {
    LAS float* sc = (LAS float*)lds;
    LAS float* red = sc + 16384;
    for (int i = tid; i < 16384; i += 512) { const int b = i >> 10, k = i & 1023; const float v = c[i]; sc[k * 16 + b] = v * fast_sigmoid(v); }
    LDS_WAIT(); __syncthreads();
    const int col = tid & 63, ks = tid >> 6; float a[16];
#pragma unroll
    for (int b = 0; b < 16; ++b) a[b] = 0.f;
    for (int k0 = ks * 128; k0 < ks * 128 + 128; k0 += 16) { float wv[16];
#pragma unroll
        for (int uu = 0; uu < 16; ++uu) wv[uu] = W[(size_t)(k0 + uu) * 6144 + cg * 64 + col];
#pragma unroll
        for (int uu = 0; uu < 16; ++uu) { const float w = wv[uu]; const LAS f32x4* s4 = (const LAS f32x4*)(sc + (k0 + uu) * 16);
#pragma unroll
            for (int q = 0; q < 4; ++q) { const f32x4 s = s4[q]; a[4 * q] += s[0] * w; a[4 * q + 1] += s[1] * w; a[4 * q + 2] += s[2] * w; a[4 * q + 3] += s[3] * w; } } }
#pragma unroll
    for (int b = 0; b < 16; ++b) red[(ks * 16 + b) * 64 + col] = a[b];
    LDS_WAIT(); __syncthreads();
    for (int o = tid; o < 1024; o += 512) { const int b = o >> 6, cc = o & 63; float s = 0.f;
#pragma unroll
        for (int q = 0; q < 8; ++q) s += red[(q * 16 + b) * 64 + cc];
        ada_l[(size_t)b * 6144 + cg * 64 + cc] = s + bias[cg * 64 + cc]; }
    LDS_WAIT(); __syncthreads();
}

__device__ __forceinline__ float reduce8(const float (&d)[8], int lane) {
    const bool b0 = lane & 1, b1 = lane & 2, b2 = lane & 4; float t[4], u[2];
#pragma unroll
    for (int i = 0; i < 4; ++i) { const float send = b0 ? d[i] : d[i + 4], keep = b0 ? d[i + 4] : d[i]; t[i] = keep + dpp_f<0xB1, 0xF, 0xF>(0.f, send); }
#pragma unroll
    for (int i = 0; i < 2; ++i) { const float send = b1 ? t[i] : t[i + 2], keep = b1 ? t[i + 2] : t[i]; u[i] = keep + dpp_f<0x4E, 0xF, 0xF>(0.f, send); }
    float v; { const float send = b2 ? u[0] : u[1], keep = b2 ? u[1] : u[0]; float x = dpp_f<0x104, 0xF, 0x5>(0.f, send); x = dpp_f<0x114, 0xF, 0xA>(x, send); v = keep + x; }
    v += dpp_f<0x128, 0xF, 0xF>(0.f, v);
    v = xor16_sum(v); v = xor32_sum(v);
    return v;
}
template <bool XBF> struct NormRaw { typedef f32x4 T; };
template <> struct NormRaw<true> { typedef u32x2 T; };
template <int NR, bool XBF>
__device__ __forceinline__ void norm_load(typename NormRaw<XBF>::T (&raw)[NR][4], const float* xin, const bf16_t* xbin, int row, int lane) {
#pragma unroll
    for (int r = 0; r < NR; ++r) {
        if constexpr (XBF) { const GAS u32x2* xr = (const GAS u32x2*)(xbin + (size_t)(row + r) * 1024) + lane;
#pragma unroll
            for (int j = 0; j < 4; ++j) raw[r][j] = xr[64 * j]; }
        else { const GAS f32x4* xr = (const GAS f32x4*)(xin + (size_t)(row + r) * 1024) + lane;
#pragma unroll
            for (int j = 0; j < 4; ++j) raw[r][j] = xr[64 * j]; } }
}
template <int MODE, int NR, int OUTK, bool XBF>
__device__ __forceinline__ void norm_proc(const typename NormRaw<XBF>::T (&raw)[NR][4], const f32x4 (&gm)[4], const f32x4 (&sh)[4], bf16_t* H, unsigned char* H8, float* SA, int row0, int i0, int wave, int lane, LAS float* W8, LAS int* tokE,
                                          int eidx, float bias_e, float* logf, int* toke, float* tokw) {
    f32x4 v[NR][4];
#pragma unroll
    for (int r = 0; r < NR; ++r)
#pragma unroll
        for (int j = 0; j < 4; ++j) { if constexpr (XBF) { const u32x2 w = raw[r][j]; v[r][j] = (f32x4){bf_lo(w.x), bf_hi(w.x), bf_lo(w.y), bf_hi(w.y)}; } else v[r][j] = raw[r][j]; }
#pragma unroll
    for (int r = 0; r < NR; ++r) {
        const int row = row0 + i0 + r; float ss = 0.f;
#pragma unroll
        for (int j = 0; j < 4; ++j) ss += (v[r][j].x * v[r][j].x + v[r][j].y * v[r][j].y) + (v[r][j].z * v[r][j].z + v[r][j].w * v[r][j].w);
        const float rstd = __builtin_amdgcn_rsqf(wave_sum(ss) * (1.0f / 1024.0f) + EPS_RMS);
#pragma unroll
        for (int j = 0; j < 4; ++j) v[r][j] = v[r][j] * rstd * gm[j] + sh[j];
        if (OUTK == 2) { float mx = 0.f;
#pragma unroll
            for (int j = 0; j < 4; ++j) mx = fmaxf(fmaxf(mx, fmaxf(fabsf(v[r][j].x), fabsf(v[r][j].y))), fmaxf(fabsf(v[r][j].z), fabsf(v[r][j].w)));
            mx = wave_max_nonneg(mx);
            const float qs = 127.0f * __builtin_amdgcn_rcpf(fmaxf(mx, 1e-30f));
            GAS unsigned* o4 = (GAS unsigned*)((GAS unsigned char*)H8 + (size_t)row * 1024) + lane;
#pragma unroll
            for (int j = 0; j < 4; ++j) o4[64 * j] = pack_i8(v[r][j].x * qs, v[r][j].y * qs, v[r][j].z * qs, v[r][j].w * qs);
            if (lane == 0) SA[row] = mx * (1.0f / 127.0f); }
        if (OUTK == 1 || OUTK == 3) { GAS unsigned* o4 = (GAS unsigned*)((GAS unsigned char*)H8 + (size_t)row * 1024) + lane;
#pragma unroll
            for (int j = 0; j < 4; ++j) { int pw = 0; pw = __builtin_amdgcn_cvt_pk_fp8_f32(v[r][j].x, v[r][j].y, pw, false); pw = __builtin_amdgcn_cvt_pk_fp8_f32(v[r][j].z, v[r][j].w, pw, true); o4[64 * j] = (unsigned)pw; } }
        if (OUTK < 2) { GAS unsigned long long* o8 = (GAS unsigned long long*)(H + (size_t)row * 1024) + lane;
#pragma unroll
            for (int j = 0; j < 4; ++j) o8[64 * j] = (unsigned long long)cvt_pk_bf16(v[r][j].x, v[r][j].y) | ((unsigned long long)cvt_pk_bf16(v[r][j].z, v[r][j].w) << 32); }
    }
    if (MODE != 0) {
        f32x2 d2[NR][4];
#pragma unroll
        for (int r = 0; r < NR; ++r)
#pragma unroll
            for (int e = 0; e < 4; ++e) d2[r][e] = (f32x2){0.f, 0.f};
        int w8o = 0; asm volatile("" : "+v"(w8o));
#pragma unroll
        for (int j = 0; j < 4; ++j)
#pragma unroll
            for (int q = 0; q < 4; ++q) { const LAS f32x4* wp = (const LAS f32x4*)(W8 + w8o + (4 * lane + 256 * j + q) * 8); const f32x4 w0 = wp[0], w1 = wp[1];
#pragma unroll
                for (int r = 0; r < NR; ++r) { const float hv = v[r][j][q]; const f32x2 h2 = (f32x2){hv, hv};
                    d2[r][0] += h2 * (f32x2){w0[0], w0[1]}; d2[r][1] += h2 * (f32x2){w0[2], w0[3]}; d2[r][2] += h2 * (f32x2){w1[0], w1[1]}; d2[r][3] += h2 * (f32x2){w1[2], w1[3]}; } }
#pragma unroll
        for (int r = 0; r < NR; ++r) { const int i = i0 + r, row = row0 + i;
            const float d[8] = {d2[r][0][0], d2[r][0][1], d2[r][1][0], d2[r][1][1], d2[r][2][0], d2[r][2][1], d2[r][3][0], d2[r][3][1]};
            const float tot = reduce8(d, lane) + bias_e;
            if (MODE == 1) {
                if (lane < 8) { const float z = tot; logf[(size_t)row * 8 + eidx] = fminf(z, 0.f) - __logf(1.0f + __expf(-fabsf(z))); }
            } else {
                float dd[8];
#pragma unroll
                for (int e = 0; e < 8; ++e) dd[e] = __int_as_float(__builtin_amdgcn_readlane(__float_as_int(tot), (e >> 2) | (((e >> 1) & 1) << 1) | ((e & 1) << 2)));
                int e0 = 0; float v0 = dd[0];
#pragma unroll
                for (int e = 1; e < 8; ++e) if (dd[e] > v0) { v0 = dd[e]; e0 = e; }
                int e1 = -1; float v1 = -INFINITY;
#pragma unroll
                for (int e = 0; e < 8; ++e) if (e != e0 && dd[e] > v1) { v1 = dd[e]; e1 = e; }
                if (lane == 0) { const float w1 = 1.0f / (1.0f + __expf(v0 - v1)), w0 = 1.0f - w1; toke[row] = e0 | (e1 << 8); *(f32x2*)(tokw + (size_t)row * 2) = (f32x2){w0, w1}; tokE[wave * 16 + i] = e0 | (e1 << 8); }
            }
        }
    }
}
struct NoSide { __device__ __forceinline__ void pre() {} __device__ __forceinline__ void post() {} };
struct MoeSide {
    MoePtrs P; int it, itEnd, lane; TrItem t; f32x4 v[16];
    __device__ __forceinline__ void pre() { if (it < itEnd) { make_moe_item(t, it, P); tr_load(v, t, lane); } }
    __device__ __forceinline__ void post() { if (it < itEnd) { tr_store(v, t, lane); it += 8; } }
};
template <int MODE, bool XBF, int OUTK, class Side>
__device__ __forceinline__ void norm_phase(LAS unsigned char* lds, int bid, int tid, int wave, int lane, const float* xin, const bf16_t* xbin, const float* gvec, const float* scv, const float* shv,
                                           bf16_t* H, unsigned char* H8, float* SA, const float* W8src, int w8pitch, const float* b8, float* logf, int* toke, float* tokw, int* cnt, Side& side) {
    LAS float* W8 = (LAS float*)lds;
    LAS int* tokE = (LAS int*)(lds + 32768);
    LAS int* cnts = tokE + 128;
    const int row0 = bid * 128 + wave * 16, b = row0 >> 11;
    constexpr int NR = (MODE == 0) ? 4 : 2;
    constexpr int NBUF = (MODE == 0) ? 3 : (MODE == 2 ? 2 : (XBF ? 4 : 2)), NBATCH = 16 / NR;
    typename NormRaw<XBF>::T raw[NBUF][NR][4];
#pragma unroll
    for (int bb = 0; bb < NBUF - 1; ++bb) norm_load<NR, XBF>(raw[bb], xin, xbin, row0 + bb * NR, lane);
    if (MODE != 0) { for (int i = tid; i < 8192; i += 512) W8[i] = W8src[(size_t)(i >> 3) * w8pitch + (i & 7)]; if (tid < 16) cnts[tid] = 0; LDS_WAIT(); __syncthreads(); }
    constexpr bool GLDS = sizeof(Side) > 4;
    LAS float* GS = (LAS float*)(lds + 36864);
    f32x4 gm[4], sh[4];
#pragma unroll
    for (int j = 0; j < 4; ++j) { const int c = 4 * lane + 256 * j; const f32x4 g = *(const f32x4*)(gvec + c), s = *(const f32x4*)(scv + (size_t)b * 6144 + c); gm[j] = g * (1.0f + s); sh[j] = *(const f32x4*)(shv + (size_t)b * 6144 + c); }
    if (GLDS) { if (wave == 0) {
#pragma unroll
            for (int j = 0; j < 4; ++j) { *(LAS f32x4*)(GS + 4 * lane + 256 * j) = gm[j]; *(LAS f32x4*)(GS + 1024 + 4 * lane + 256 * j) = sh[j]; } }
        LDS_WAIT(); __syncthreads(); }
    const int eidx = 4 * (lane & 1) + 2 * ((lane >> 1) & 1) + ((lane >> 2) & 1);
    float bias_e = 0.f; if (MODE != 0) bias_e = b8[eidx];
#pragma unroll
    for (int bb = 0; bb < NBATCH; ++bb) {
        if ((bb & 1) == 0) side.pre();
        if (bb + NBUF - 1 < NBATCH) norm_load<NR, XBF>(raw[(bb + NBUF - 1) % NBUF], xin, xbin, row0 + (bb + NBUF - 1) * NR, lane);
        if (GLDS) { int go = 0; asm volatile("" : "+v"(go));
            f32x4 gmb[4], shb[4];
#pragma unroll
            for (int j = 0; j < 4; ++j) { gmb[j] = *(const LAS f32x4*)(GS + go + 4 * lane + 256 * j); shb[j] = *(const LAS f32x4*)(GS + go + 1024 + 4 * lane + 256 * j); }
            norm_proc<MODE, NR, OUTK, XBF>(raw[bb % NBUF], gmb, shb, H, H8, SA, row0, bb * NR, wave, lane, W8, tokE, eidx, bias_e, logf, toke, tokw); }
        else norm_proc<MODE, NR, OUTK, XBF>(raw[bb % NBUF], gm, sh, H, H8, SA, row0, bb * NR, wave, lane, W8, tokE, eidx, bias_e, logf, toke, tokw);
        if ((bb & 1) == 1) side.post();
    }
    if (MODE == 2) {
        LDS_WAIT(); __syncthreads();
        if (tid < 128) { const int ee = tokE[tid]; const int e0 = ee & 255, e1 = ee >> 8;
#pragma unroll
            for (int e = 0; e < 8; ++e) { const unsigned long long m0 = __ballot(e0 == e), m1 = __ballot(e1 == e);
                if (lane == 0) { __hip_atomic_fetch_add(&cnts[e], (int)__popcll(m0), __ATOMIC_RELAXED, __HIP_MEMORY_SCOPE_WORKGROUP); __hip_atomic_fetch_add(&cnts[8 + e], (int)__popcll(m1), __ATOMIC_RELAXED, __HIP_MEMORY_SCOPE_WORKGROUP); } } }
        LDS_WAIT(); __syncthreads();
        if (tid < 16) cnt[bid * 16 + tid] = cnts[tid];
        LDS_WAIT(); __syncthreads();
    }
}

template <int HALFSEL>
__device__ __forceinline__ void final_phase(int bid, int wave, int lane, float* out, const bf16_t* xb, bf16_t* tmpx, const float* g, const float* gate, const int* LS, const float* tokw, const float* slab) {
    constexpr int ROWS = (HALFSEL == 2) ? 16 : 8;
    const int lrow0 = bid * (8 * ROWS) + wave * ROWS; f32x4 gm[4];
#pragma unroll
    for (int j = 0; j < 4; ++j) gm[j] = *(const f32x4*)(g + 4 * lane + 256 * j);
    const bf16_t* src = HALFSEL == 1 ? tmpx : xb; const int rbase = HALFSEL == 1 ? 16384 : 0;
    for (int i0 = 0; i0 < ROWS; i0 += 4) { f32x4 v[4][4]; u32x2 cp[4][4];
#pragma unroll
        for (int r = 0; r < 4; ++r) { const GAS u32x2* xr = (const GAS u32x2*)(src + (size_t)(lrow0 + i0 + r) * 1024) + lane;
#pragma unroll
            for (int j = 0; j < 4; ++j) { const u32x2 w = xr[64 * j]; v[r][j] = (f32x4){bf_lo(w.x), bf_hi(w.x), bf_lo(w.y), bf_hi(w.y)}; }
            if (HALFSEL == 0) { const GAS u32x2* xc = (const GAS u32x2*)(xb + (size_t)(16384 + lrow0 + i0 + r) * 1024) + lane;
#pragma unroll
                for (int j = 0; j < 4; ++j) cp[r][j] = xc[64 * j]; } }
#pragma unroll
        for (int r = 0; r < 4; ++r) { const int row = rbase + lrow0 + i0 + r, b = row >> 11;
            if (HALFSEL == 0) { GAS u32x2* tc = (GAS u32x2*)(tmpx + (size_t)(lrow0 + i0 + r) * 1024) + lane;
#pragma unroll
                for (int j = 0; j < 4; ++j) tc[64 * j] = cp[r][j]; }
#pragma unroll
            for (int k = 0; k < 2; ++k) { const int ls = __builtin_amdgcn_readfirstlane(__hip_atomic_load(LS + (size_t)row * 2 + k, RLX_AGENT));
                if (ls >= 0) { const float w = __hip_atomic_load(tokw + (size_t)row * 2 + k, RLX_AGENT);
#pragma unroll
                    for (int j = 0; j < 4; ++j) { const int c = 4 * lane + 256 * j; const f32x4 gt = *(const f32x4*)(gate + (size_t)b * 6144 + c);
                        const f32x4 s0 = *(const f32x4*)(slab + (size_t)ls * 1024 + c) + *(const f32x4*)(slab + ((size_t)SLAB_ROWS + ls) * 1024 + c) + *(const f32x4*)(slab + ((size_t)2 * SLAB_ROWS + ls) * 1024 + c);
                        v[r][j] += (gt * w) * s0; } } }
            float ss = 0.f;
#pragma unroll
            for (int j = 0; j < 4; ++j) ss += (v[r][j].x * v[r][j].x + v[r][j].y * v[r][j].y) + (v[r][j].z * v[r][j].z + v[r][j].w * v[r][j].w);
            const float rstd = 1.0f / sqrtf(wave_sum(ss) * (1.0f / 1024.0f) + EPS_RMS);
            GAS f32x4* orow = (GAS f32x4*)(out + (size_t)row * 1024) + lane;
#pragma unroll
            for (int j = 0; j < 4; ++j) orow[64 * j] = v[r][j] * rstd * gm[j]; } }
}

__device__ __forceinline__ void cumsum_bh(int b, int h, int lane, const float* logf, float* Fl2) {
    float pref[32]; float s = 0.f; const int t0 = 32 * lane;
#pragma unroll
    for (int i = 0; i < 32; ++i) { s += logf[((size_t)b * 2048 + t0 + i) * 8 + h]; pref[i] = s; }
    float incl = s;
#pragma unroll
    for (int o = 1; o < 64; o <<= 1) { const float n = __shfl_up(incl, o); if (lane >= o) incl += n; }
    const float excl = incl - s; float* out = Fl2 + (size_t)(b * 8 + h) * 2048 + t0;
#pragma unroll
    for (int i = 0; i < 32; i += 4) *(f32x4*)(out + i) = (f32x4){(excl + pref[i]) * LOG2E, (excl + pref[i + 1]) * LOG2E, (excl + pref[i + 2]) * LOG2E, (excl + pref[i + 3]) * LOG2E};
}

__device__ __forceinline__ void scan_item(int g, int b, int lane, const float* Sloc, bf16_t* AU, const float* A32l) {
    const f32x2 a = *(const f32x2*)(A32l + (size_t)(g * 64 + lane) * 2); float sr = 0.f, si = 0.f;
    const size_t row0 = (size_t)g * 1024 + (size_t)b * 64;
    for (int c0 = 0; c0 < 64; c0 += 8) { f32x2 loc[8];
#pragma unroll
        for (int j = 0; j < 8; ++j) loc[j] = *(const f32x2*)(Sloc + (row0 + c0 + j) * 128 + 2 * lane);
#pragma unroll
        for (int j = 0; j < 8; ++j) { *(GAS unsigned*)(AU + (row0 + c0 + j) * 640 + 512 + 2 * lane) = cvt_pk_bf16(sr, si);
            const float nr = a.x * sr - a.y * si + loc[j].x, ni = a.x * si + a.y * sr + loc[j].y; sr = nr; si = ni; } }
}

__device__ __forceinline__ void sort_phase(LAS unsigned char* lds, int bid, int tid, int lane, const int* toke, const float* tokw, const int* cnt, unsigned char* sortb, int* LS) {
    LAS int* call = (LAS int*)lds;
    LAS int* offs = call + 4096;
    LAS int* tot = offs + 16;
    LAS int* w0c = tot + 16;
    int* rowlist = (int*)(sortb + SORT_ROWLIST); float* slotw = (float*)(sortb + SORT_SLOTW); int* pexp = (int*)(sortb + SORT_PEXP); int* np = (int*)(sortb + SORT_NP);
    for (int i = tid; i < 4096; i += 512) call[i] = __hip_atomic_load(cnt + i, RLX_AGENT);
    LDS_WAIT(); __syncthreads();
    if (tid < 16) { int before = 0, total = 0; for (int w = 0; w < 256; ++w) { const int c = call[w * 16 + tid]; if (w < bid) before += c; total += c; } offs[tid] = before; tot[tid] = total; }
    LDS_WAIT(); __syncthreads();
    if (tid < 16) { const int k = tid >> 3, e = tid & 7; int base = 0; for (int e2 = 0; e2 < e; ++e2) base += (tot[k * 8 + e2] + 255) & ~255; offs[tid] += base; }
    LDS_WAIT(); __syncthreads();
    int ee = 0, e0 = 0, e1 = 0, r0 = 0, r1 = 0;
    if (tid < 128) { ee = __hip_atomic_load(toke + bid * 128 + tid, RLX_AGENT); e0 = ee & 255; e1 = ee >> 8;
#pragma unroll
        for (int e = 0; e < 8; ++e) { const unsigned long long m0 = __ballot(e0 == e), m1 = __ballot(e1 == e); const unsigned long long lt = (1ull << lane) - 1ull;
            if (e0 == e) r0 = (int)__popcll(m0 & lt); if (e1 == e) r1 = (int)__popcll(m1 & lt);
            if (tid < 64 && lane == 0) { w0c[e] = (int)__popcll(m0); w0c[8 + e] = (int)__popcll(m1); } } }
    LDS_WAIT(); __syncthreads();
    if (tid < 128) { if (tid >= 64) { r0 += w0c[e0]; r1 += w0c[8 + e1]; }
        const int token = bid * 128 + tid; const int s0 = offs[e0] + r0, s1 = offs[8 + e1] + r1;
        const float w0 = __hip_atomic_load(tokw + (size_t)token * 2, RLX_AGENT), w1 = __hip_atomic_load(tokw + (size_t)token * 2 + 1, RLX_AGENT);
        rowlist[s0] = token; slotw[s0] = w0; rowlist[SLOT_CAP + s1] = token; slotw[SLOT_CAP + s1] = w1;
        int n0 = 0;
#pragma unroll
        for (int e = 0; e < 8; ++e) n0 += (tot[e] + 255) >> 8;
        LS[token * 2] = (s0 >> 8) >= 128 ? (((s0 >> 8) - 128) << 8) + (s0 & 255) : -1;
        LS[token * 2 + 1] = (s1 >> 8) >= 128 ? (((n0 - 128) + (s1 >> 8) - 128) << 8) + (s1 & 255) : -1; }
    if (bid == 0) {
        if (tid < 16) { const int k = tid >> 3, e = tid & 7; int base = 0; for (int e2 = 0; e2 < e; ++e2) base += (tot[k * 8 + e2] + 255) & ~255;
            const int t = tot[tid], pe = (t + 255) & ~255;
            for (int s = base + t; s < base + pe; ++s) { rowlist[k * SLOT_CAP + s] = -1; slotw[k * SLOT_CAP + s] = 0.f; }
            for (int p = base >> 8; p < (base + pe) >> 8; ++p) pexp[k * 136 + p] = e;
            if (e == 7) np[k] = (base + pe) >> 8; }
        if (tid == 0) {
            int* panel = (int*)(sortb + SORT_PANEL); int* npc = (int*)(sortb + SORT_NPC); int n0 = 0, n1 = 0;
            for (int e = 0; e < 8; ++e) { n0 += (tot[e] + 255) >> 8; n1 += (tot[8 + e] + 255) >> 8; }
            for (int p = 0; p < 128; ++p) { panel[p] = p; panel[136 + p] = 136 + p; }
            int c = 0; for (int p = 128; p < n0; ++p) panel[272 + c++] = p; for (int p = 128; p < n1; ++p) panel[272 + c++] = 136 + p;
            npc[0] = 128; npc[1] = 128; npc[2] = c;
            int* panelm = (int*)(sortb + SORT_PANELM); for (int p = 0; p < 128; ++p) panelm[p] = 136 + p; for (int i = 0; i < c; ++i) panelm[128 + i] = panel[272 + i];
            *(int*)(sortb + SORT_NPM) = 128 + c; } }
    LDS_WAIT(); __syncthreads();
}

#ifndef MK_MULTI
#define MK_MULTI 0
#endif
constexpr int LSTRIDE = 18, NPHASE = 3 + 2 * LSTRIDE, PH_FINAL = 1 + 2 * LSTRIDE;
struct Args { const float* in[31]; float* out; unsigned char* ws; int ph_lo, ph_hi, aux, pad; };
static_assert(sizeof(Args) == 31 * 8 + 8 + 8 + 16, "Args has no padding");

#ifndef PHASE_MASK
#define PHASE_MASK 0xFFFFFFFFu
#endif
#define HAVE(j) ((PHASE_MASK >> (j)) & 1u)
#define IN(k) (lo <= (k) && (k) < hi)
#define INP(i) ((const float*)ld_ptr(PT, (i)))
#define WSP(T, off) ((T*)((unsigned char*)ld_ptr(PT, 32) + (off)))
#define XRES ((float*)ld_ptr(PT, 31))
#define XBP WSP(bf16_t, WS_XB)
#define WUP8P ((unsigned char*)ld_ptr(PT, 31))
#define SEAM(k) do { if (IN(k) && IN((k) + 1)) { XcdBarrier bar_; bar_.bar = WSP(unsigned, WS_CTL) + CW_BAR; bar_.x = xb_xcc_id(); bar_.st = MISC + 8; xcd_barrier(bar_); } } while (0)
#define IDS int tid = threadIdx.x, bid = blockIdx.x, G = gridDim.x; asm volatile("" : "+v"(tid), "+s"(bid), "+s"(G)); \
    const int lane = tid & 63, wave = __builtin_amdgcn_readfirstlane(tid >> 6); const int vcu = (G % 8 == 0) ? (bid % 8) * (G / 8) + bid / 8 : bid; \
    const int gw = vcu * NWAVES + wave, NGW = G * NWAVES; (void)lane; (void)gw; (void)NGW; (void)vcu

template <int l>
__device__ __forceinline__ void layer_phases(LAS unsigned char* lds, unsigned char* lds_raw, LAS unsigned long long* PT, volatile LAS unsigned* MISC, const int lo, const int hi, const int args_aux) {

        constexpr int P = 1 + LSTRIDE * l;
#undef ADA_L
#define ADA_L (WSP(float, WS_ADA) + (size_t)l * 16 * 6144)
#undef XCUR
#define XCUR ((l == 0) ? INP(0) : (const float*)XRES)
        if (HAVE(0) && IN(P + 0)) { IDS; const float* ada_l = ADA_L;
            if (l == 0) {
                if (bid < 64) { const int ll = bid >> 5, g = bid & 31; const size_t lg = (size_t)ll * 32 + g;
                    s5_gen(lds, tid, INP(8) + lg * 64, INP(9) + lg * 64, INP(10) + lg, INP(11) + lg * 1024, INP(12) + lg * 1024, INP(13) + lg * 1024, INP(14) + lg * 1024,
                           WSP(bf16_t, WS_TG) + lg * 512 * 640, WSP(bf16_t, WS_WST) + lg * 256 * 512, WSP(float, WS_A32) + lg * 128);
                } else {
                    const P0Ptrs PP{INP(5), INP(16), INP(18), INP(19), INP(20), INP(22), INP(23), INP(24), WSP(bf16_t, WS_WIN), WSP(bf16_t, WS_WGLU), WSP(bf16_t, WS_WPA), WSP(bf16_t, WS_WPS), WSP(bf16_t, WS_WOUT), WSP(bf16_t, WS_WUPD), WSP(bf16_t, WS_WDND), WSP(float, WS_CTL) + CW_CMAX};
                    TR_LOOP((bid - 64) * NWAVES + wave, TI_P0, (G - 64) * NWAVES, make_p0_item, PP);
                }
                __syncthreads();
            }
            NoSide ns_; norm_phase<1, (l != 0), 2, NoSide>(lds, bid, tid, wave, lane, INP(0), XBP, INP(4) + l * 1024, ada_l + 1024, ada_l, nullptr, WSP(unsigned char, WS_Y), WSP(float, WS_SA1), INP(5) + (size_t)l * 1024 * NIN_SRC + 1536, NIN_SRC, INP(6) + l * 8, WSP(float, WS_LOGF), nullptr, nullptr, nullptr, ns_); }
        SEAM(P + 0);
        if (HAVE(1) && IN(P + 1)) { IDS;
            {
                pg8::ProbPlainI8 S{WSP(bf16_t, WS_Y), WSP(bf16_t, WS_WIN) + (size_t)l * WIN_LSTRIDE, 512, 512, 512, {}}; S.ord.init(128, 16, G, bid);
                pg8::EpiIn<true> E{WSP(bf16_t, WS_Q), WSP(bf16_t, WS_AU), WSP(bf16_t, WS_GATES), INP(7) + l * 2048, 0, WSP(float, WS_SA1), WSP(unsigned, WS_CTL) + CW_CMAX + l * 4096};
                pg8::gemm_phase<pg8::EpiIn<true>, pg8::ProbPlainI8, true>(lds, S, E); }
        }
        SEAM(P + 1);
        if (HAVE(2) && IN(P + 2)) { IDS;
            if (bid >= G - 16) cumsum_bh(bid - (G - 16), wave, lane, WSP(float, WS_LOGF), WSP(float, WS_FL2));
            if (bid >= 128 && bid < 240) { const MoePtrs MP{INP(27), INP(28), INP(29), nullptr, WSP(bf16_t, WS_WDNM), WUP8P};
                const int r0 = (l * 112 + (bid - 128)) * MOE_R_S5; TR_LOOP(r0 * 8 + wave, (r0 + MOE_R_S5) * 8, 8, make_moe_item, MP); }
            pg8::ProbS5b S{WSP(bf16_t, WS_AU), WSP(bf16_t, WS_WST) + (size_t)l * 32 * 256 * 512, 512, 640, 512, {}}; S.ord.init(128, 1, G, bid);
            pg8::EpiS5b E{WSP(float, WS_SLOC)};
            pg8::gemm_phase<pg8::EpiS5b, pg8::ProbS5b, false>(lds, S, E);
            { pg8::Unit u0; if (S.ord.next(0, u0)) { VM_WAIT(); __syncthreads();
                if (wave < 4) scan_item(u0.pm >> 2, (u0.pm & 3) * 4 + wave, lane, WSP(float, WS_SLOC), WSP(bf16_t, WS_AU), WSP(float, WS_A32) + (size_t)l * 32 * 128); } }
        }
        SEAM(P + 2);
        if (HAVE(4) && IN(P + 4)) { IDS;
            pg8::ProbS5ad S{WSP(bf16_t, WS_AU), WSP(bf16_t, WS_TG) + (size_t)l * 32 * 512 * 640, 640, 640, 640, {}}; S.ord.init(128, 2, G, bid);
            pg8::EpiS5ad E{WSP(bf16_t, WS_AU), WSP(bf16_t, WS_Y), INP(15) + l * 512};
            pg8::gemm_phase<pg8::EpiS5ad, pg8::ProbS5ad, false>(lds, S, E);
        }
        SEAM(P + 4);
        if (HAVE(5) && IN(P + 5)) { IDS;
            pg8::ProbPlain S{WSP(bf16_t, WS_Y), WSP(bf16_t, WS_WGLU) + (size_t)l * 512 * 512, 512, 512, 512, {}}; S.ord.init(128, 2, G, bid);
            pg8::EpiGlu E{WSP(bf16_t, WS_Y), WSP(bf16_t, WS_Y2), INP(17) + l * 512};
            pg8::gemm_phase<pg8::EpiGlu, pg8::ProbPlain, false>(lds, S, E);
        }
        if (HAVE(6) && IN(P + 6)) { IDS;
            const attn_body::AttnTensors AT{WSP(const attn_body::bf16, WS_Q), WSP(const attn_body::bf16, WS_K), WSP(const attn_body::bf16, WS_V), (args_aux == 1) ? WSP(attn_body::bf16, WS_Y) : WSP(attn_body::bf16, WS_Q), WSP(const float, WS_FL2)};
            const attn_body::StaticOrder S(G, bid);
            attn_body::attn_phase<attn_body::StaticOrder>((char*)lds_raw, AT, S);
        }
        SEAM(P + 6);
        if (HAVE(7) && IN(P + 7)) { IDS;
            pg8::ProbProj2 S{WSP(bf16_t, WS_Q), (long)WS_Y2 - (long)WS_Q, WSP(bf16_t, WS_WPA) + (size_t)l * 1024 * 512, (long)WS_WPS - (long)WS_WPA, 512, 512, 512, {}}; S.ord.init(128, 4, G, bid);
            pg8::EpiProj2 E{WSP(bf16_t, WS_GATES), WSP(bf16_t, WS_MIX)};
            pg8::gemm_phase<pg8::EpiProj2, pg8::ProbProj2, true>(lds, S, E);
        }
        SEAM(P + 7);
        if (HAVE(9) && IN(P + 9)) { IDS;
            pg8::ProbPlain S{WSP(bf16_t, WS_MIX), WSP(bf16_t, WS_WOUT) + (size_t)l * 1024 * 1024, 1024, 1024, 1024, {}}; S.ord.init(128, 4, G, bid);
            pg8::EpiOut<(l == 0)> E{INP(0), XBP, ADA_L + 2 * 1024, args_aux == 1 ? 0.f : 1.f};
            pg8::gemm_phase<pg8::EpiOut<(l == 0)>, pg8::ProbPlain, true>(lds, S, E);
        }
        SEAM(P + 9);
        if (HAVE(10) && IN(P + 10)) { IDS; const float* ada_l = ADA_L;
            NoSide ns2_; if (l == 0) norm_phase<0, true, 2, NoSide>(lds, bid, tid, wave, lane, nullptr, XBP, INP(21) + l * 1024, ada_l + 4 * 1024, ada_l + 3 * 1024, nullptr, WSP(unsigned char, WS_H8), WSP(float, WS_SA2), nullptr, 0, nullptr, nullptr, nullptr, nullptr, nullptr, ns2_);
            else { unsigned char* SORTB = WSP(unsigned char, WS_SORT);
                MoeSide side_; side_.P = MoePtrs{INP(27), INP(28), INP(29), nullptr, WSP(bf16_t, WS_WDNM), WUP8P}; side_.it = (MOE_R_NORM0 + vcu * MOE_R_NORM_EACH) * 8 + wave; side_.itEnd = (MOE_R_NORM0 + (vcu + 1) * MOE_R_NORM_EACH) * 8; side_.lane = lane;
                norm_phase<2, true, 3, MoeSide>(lds, bid, tid, wave, lane, nullptr, XBP, INP(21) + l * 1024, ada_l + 4 * 1024, ada_l + 3 * 1024, nullptr, WSP(unsigned char, WS_H8), nullptr, INP(25), 8, INP(26), nullptr, WSP(int, WS_TOKE), WSP(float, WS_TOKW), (int*)(SORTB + SORT_CNT), side_);
                const MoePtrs MP{INP(27), INP(28), INP(29), nullptr, WSP(bf16_t, WS_WDNM), WUP8P};
                if (MOE_R_TAIL0 + vcu < MOE_ROUNDS) { const int it9 = (MOE_R_TAIL0 + vcu) * 8 + wave; TR_LOOP(it9, it9 + 1, 8, make_moe_item, MP); } }
        }
        SEAM(P + 10);
        if (HAVE(11) && IN(P + 11) && l == 1) { IDS;
            { unsigned char* SORTB = WSP(unsigned char, WS_SORT); sort_phase(lds, bid, tid, lane, WSP(int, WS_TOKE), WSP(float, WS_TOKW), (int*)(SORTB + SORT_CNT), SORTB, WSP(int, WS_LS)); }
            if (bid != 0) { const MoePtrs MP{INP(27), INP(28), INP(29), nullptr, WSP(bf16_t, WS_WDNM), WUP8P};
                const int it1 = (MOE_R_SORT0 + bid - 1) * 8 + wave; TR_LOOP(it1, it1 + 1, 8, make_moe_item, MP); }
        }
        if (l == 1) SEAM(P + 11);
        for (int k = 0; k < (l == 0 ? 1 : 3); ++k) {
            if (HAVE(12) && IN(P + 12 + 2 * k) && !(l == 1 && k == 2)) { IDS;
                unsigned char* SORTB = WSP(unsigned char, WS_SORT);
                const int np = __builtin_amdgcn_readfirstlane(__hip_atomic_load((l == 1 && k == 1) ? (int*)(SORTB + SORT_NPM) : (int*)(SORTB + SORT_NPC) + k, RLX_AGENT));
                if (l == 1) {
                    pg8::ProbUp8 S{WSP(bf16_t, WS_H8), (bf16_t*)WUP8P, (int*)(SORTB + SORT_ROWLIST), (int*)(SORTB + SORT_PEXP), (k == 1) ? (int*)(SORTB + SORT_PANELM) : (int*)(SORTB + SORT_PANEL) + k * 136, 512, 512, 512, {}}; S.ord.init(np, 22, G, bid);
                    pg8::EpiUp<true, false> E{WSP(bf16_t, WS_HID + (size_t)(k == 0 ? 0 : 128) * 256 * DFF), nullptr, nullptr};
                    pg8::gemm_phase<pg8::EpiUp<true, false>, pg8::ProbUp8, true>(lds, S, E);
                } else {
                    pg8::ProbPlainI8 S{WSP(bf16_t, WS_H8), WSP(bf16_t, WS_WUPD), 512, 512, 512, {}}; S.ord.init(128, 22, G, bid);
                    pg8::EpiUp<(DENSE_DOWN_FP8 != 0), true> E{WSP(bf16_t, WS_HID), WSP(float, WS_SA2), WSP(unsigned, WS_CTL) + CW_CMAX + 8192};
                    pg8::gemm_phase<pg8::EpiUp<(DENSE_DOWN_FP8 != 0), true>, pg8::ProbPlainI8, true>(lds, S, E);
                }
            }
            if (!(l == 1 && k == 2)) SEAM(P + 12 + 2 * k);
            if (HAVE(13) && IN(P + 13 + 2 * k)) { IDS;
                unsigned char* SORTB = WSP(unsigned char, WS_SORT);
                const int np = __builtin_amdgcn_readfirstlane(__hip_atomic_load((int*)(SORTB + SORT_NPC) + k, RLX_AGENT));
                if (l == 0 && !DENSE_DOWN_FP8) {
                    pg8::ProbDown S{WSP(bf16_t, WS_HID), WSP(bf16_t, WS_WDND), (int*)(SORTB + SORT_PEXP), (int*)(SORTB + SORT_PANEL) + k * 136, DFF, DFF, DFF, {}}; S.ord.init(np, 4, G, bid);
                    pg8::EpiDown E{XBP, ADA_L + 5 * 1024, (int*)(SORTB + SORT_ROWLIST), (float*)(SORTB + SORT_SLOTW), (int*)(SORTB + SORT_PANEL) + k * 136, args_aux == 1 ? 0.f : 1.f};
                    pg8::gemm_phase<pg8::EpiDown, pg8::ProbDown, true>(lds, S, E);
                } else if (k < 2) {
                    pg8::ProbDown8 S{WSP(bf16_t, WS_HID + (size_t)((l == 1 && k == 1) ? 128 : 0) * 256 * DFF), (l == 0) ? WSP(bf16_t, WS_WDND) : WSP(bf16_t, WS_WDNM), (int*)(SORTB + SORT_PEXP), (int*)(SORTB + SORT_PANEL) + k * 136, DFF / 2, DFF / 2, DFF / 2, {}}; S.ord.init(np, 4, G, bid);
                    pg8::EpiDown E{XBP, ADA_L + 5 * 1024, (int*)(SORTB + SORT_ROWLIST), (float*)(SORTB + SORT_SLOTW), (int*)(SORTB + SORT_PANEL) + k * 136, args_aux == 1 ? 0.f : 1.f};
                    pg8::gemm_phase<pg8::EpiDown, pg8::ProbDown8, true>(lds, S, E);
                } else {
                    pg8::ProbDown8S S{WSP(bf16_t, WS_HID + (size_t)256 * 256 * DFF), WSP(bf16_t, WS_WDNM), (int*)(SORTB + SORT_PEXP), (int*)(SORTB + SORT_PANEL) + k * 136, DFF / 2, DFF / 2, DFF / 2, {}}; S.ord.init(np, 12, G, bid);
                    pg8::EpiSlab E{WSP(float, WS_SL)};
                    pg8::gemm_phase<pg8::EpiSlab, pg8::ProbDown8S, false>(lds, S, E);
                }
            }
            if (!(l == 1 && k < 2)) SEAM(P + 13 + 2 * k);
        }
    }

__global__ void __launch_bounds__(NWAVES * 64, 2) fwd_kernel(Args args) {
    extern __shared__ __attribute__((aligned(16))) unsigned char lds_raw[];
    LAS unsigned char* lds = (LAS unsigned char*)lds_raw;
    volatile LAS unsigned* MISC = (volatile LAS unsigned*)(lds + MISC_OFF);
    const int tid0 = threadIdx.x;
    for (int u = tid0; u < (LDS_BYTES - LDSCTL_OFF) / 4; u += NWAVES * 64) ((LAS unsigned*)(lds + LDSCTL_OFF))[u] = 0u;
    __syncthreads();
    const int lo = args.ph_lo, hi = args.ph_hi;
    if (hi - lo > 1) (void)xcd_barrier_post((unsigned*)(args.ws + WS_CTL) + CW_BAR, MISC + 8);

    LAS unsigned long long* PT = (LAS unsigned long long*)(lds + LDSCTL_OFF + 1024);
    if (tid0 < 31) PT[tid0] = (unsigned long long)args.in[tid0];
    if (tid0 == 31) PT[31] = (unsigned long long)args.out;
    if (tid0 == 32) PT[32] = (unsigned long long)args.ws;
    LDS_WAIT(); __syncthreads();

    if (HAVE(16) && IN(0)) { IDS;
        for (int it = G - 1 - bid; it < CM_ITEMS; it += G) {
            float* CM = WSP(float, WS_CTL) + CW_CMAX;
            if (it < 128) { const int l = it >> 6, n0 = 64 * (it & 63); colmax_item(lds, tid, INP(5) + (size_t)l * 1024 * NIN_SRC, NIN_SRC, n0 < 1536 ? n0 : n0 + 8, CM + l * 4096 + n0); }
            else { const int r = it - 128, which = r / 44, nb = r % 44; colmax_item(lds, tid, which ? INP(23) : INP(22), DFF, 64 * nb, CM + 8192 + up_row(64 * nb, which)); } }
        for (int it = bid; it < 192; it += G) { const int l = it / 96, cg = it % 96; ada_item(lds, tid, INP(1), INP(2) + (size_t)l * 1024 * 6144, INP(3) + (size_t)l * 6144, WSP(float, WS_ADA) + (size_t)l * 16 * 6144, cg); }
        { unsigned char* SORTB = WSP(unsigned char, WS_SORT); int* ROWLIST = (int*)(SORTB + SORT_ROWLIST); float* SLOTW = (float*)(SORTB + SORT_SLOTW); int* PEXP = (int*)(SORTB + SORT_PEXP); int* NP = (int*)(SORTB + SORT_NP);
          for (int i = bid * 512 + tid; i < TOK; i += G * 512) { ROWLIST[i] = i; SLOTW[i] = 1.0f; }
          if (bid == 0 && tid < 136) { PEXP[tid] = 0; ((int*)(SORTB + SORT_PANEL))[tid] = tid; }
          if (bid == 0 && tid == 0) { NP[0] = 128; ((int*)(SORTB + SORT_NPC))[0] = 128; } }
    }
    SEAM(0);

    layer_phases<0>(lds, lds_raw, PT, MISC, lo, hi, args.aux);
    layer_phases<1>(lds, lds_raw, PT, MISC, lo, hi, args.aux);
    if (HAVE(17) && IN(PH_FINAL)) { IDS; final_phase<2>(bid, wave, lane, XRES, XBP, nullptr, INP(30), WSP(float, WS_ADA) + (size_t)16 * 6144 + 5 * 1024, WSP(int, WS_LS), WSP(float, WS_TOKW), WSP(float, WS_SL)); }
}

extern "C" void kernel_launch(void* const* d_in, const int* in_sizes, int n_in, void* d_out, int out_size, void* d_ws, size_t ws_size, hipStream_t stream) {
    static int grid = 0;
    if (grid == 0) {
        if (n_in != 31 || out_size != TOK * DMODEL || ws_size < WS_END) { fprintf(stderr, "kernel_launch: unexpected problem (n_in %d out %d ws %zu)\n", n_in, out_size, ws_size); grid = -1; return; }
        int dev = 0, cus = 0, per_cu = 0;
        if (hipGetDevice(&dev) != hipSuccess || hipDeviceGetAttribute(&cus, hipDeviceAttributeMultiprocessorCount, dev) != hipSuccess) { grid = -1; return; }
        if (hipFuncSetAttribute((const void*)fwd_kernel, hipFuncAttributeMaxDynamicSharedMemorySize, LDS_BYTES) != hipSuccess) { fprintf(stderr, "kernel_launch: hipFuncSetAttribute failed\n"); grid = -1; return; }
        if (hipOccupancyMaxActiveBlocksPerMultiprocessor(&per_cu, (const void*)fwd_kernel, NWAVES * 64, LDS_BYTES) != hipSuccess || per_cu < 1) fprintf(stderr, "kernel_launch: occupancy query reports %d\n", per_cu);
        (void)hipGetLastError();
        grid = cus < 256 ? cus : 256;
    }
    if (grid < 0) return;
    if (hipMemsetAsync((char*)d_ws + WS_CTL, 0, CTL_ZERO_BYTES, stream) != hipSuccess) return;
    Args a{};
    for (int i = 0; i < 31; ++i) a.in[i] = (const float*)d_in[i];
    a.out = (float*)d_out; a.ws = (unsigned char*)d_ws;
#if MK_MULTI
#ifndef LAST_PHASE
#define LAST_PHASE (NPHASE - 1)
#endif
#ifdef DUMP_OFF
#endif
    for (int p = 0; p <= LAST_PHASE; ++p) { if (p == 12 || (p >= 15 && p <= 18)) continue; a.ph_lo = p; a.ph_hi = p + 1;
#ifdef REP_LIST
        { const int reps[] = REP_LIST; for (int r : reps) if (r == p) { a.aux = 1; hipLaunchKernelGGL(fwd_kernel, dim3(grid), dim3(NWAVES * 64), LDS_BYTES, stream, a); a.aux = 0; } }
#endif
        hipLaunchKernelGGL(fwd_kernel, dim3(grid), dim3(NWAVES * 64), LDS_BYTES, stream, a); }
#ifdef DUMP_OFF
    a.ph_lo = NPHASE; a.ph_hi = NPHASE + 1; hipLaunchKernelGGL(fwd_kernel, dim3(grid), dim3(NWAVES * 64), LDS_BYTES, stream, a);
#endif
#else
    a.ph_lo = 0; a.ph_hi = NPHASE;
    hipLaunchKernelGGL(fwd_kernel, dim3(grid), dim3(NWAVES * 64), LDS_BYTES, stream, a);
#endif
}
```
